# Optimizing an MI355X kernel written in HIP

```python
import math
import jax
import jax.numpy as jnp
from jax import lax
import numpy as np

D_MODEL = 1024
BATCH = 2
SEQ = 16384
DEPTH = 4

GRID_W = 64
CTX_LEN = 256
N_MOD = 6
NORM_EPS = 1e-6
N_DIFF_HEADS = 4
DIFF_HEAD_DIM = 64
DIFF_V_DIM = 2 * DIFF_HEAD_DIM
ATTN_QK = N_DIFF_HEADS * 2 * DIFF_HEAD_DIM
ATTN_V = N_DIFF_HEADS * DIFF_V_DIM
Q_BLOCK = 128
ROPE_BASE = 10000.0
S5_WIDTH = 512
S5_GROUP = 16
S5_GROUPS = S5_WIDTH // S5_GROUP
S5_STATE = 64
MLSTM_HEADS = 4
MLSTM_HEAD_DIM = 128
MLSTM_WIDTH = MLSTM_HEADS * MLSTM_HEAD_DIM
MLSTM_GATES = 2 * 2 * MLSTM_HEADS
MLSTM_CHUNK = 128
CONV_K = 5
N_BRANCH = 3
BRANCH_WIDTH = 512
IN_SIZES = (ATTN_QK, ATTN_QK, ATTN_V, S5_WIDTH, MLSTM_WIDTH, MLSTM_WIDTH, MLSTM_WIDTH, MLSTM_WIDTH, MLSTM_GATES, N_BRANCH * D_MODEL)
D_IN = 2 * ATTN_QK + ATTN_V + S5_WIDTH + 4 * MLSTM_WIDTH + MLSTM_GATES + N_BRANCH * D_MODEL
N_EXPERTS = 16
D_EXPERT = 2048
CAPACITY_FACTOR = 2

kernel_name = 'hybrid_diffattn_s5_mlstm_ecmoe_prefix_block'


def rms_norm(t):
    tf = t.astype(jnp.float32)
    return (tf * lax.rsqrt(jnp.mean(tf * tf, axis=-1, keepdims=True) + NORM_EPS)).astype(t.dtype)


def modulate(t, shift, scale):
    return rms_norm(t) * (1.0 + scale) + shift


def split_projection(p):
    cuts = [int(v) for v in np.cumsum(IN_SIZES)[:-1]]
    return jnp.split(p, cuts, axis=-1)


def axial_rope_tables(rows):
    n_freq = DIFF_HEAD_DIM // 4
    inv_freq = ROPE_BASE ** (-jnp.arange(n_freq, dtype=jnp.float32) / n_freq)
    t = jnp.arange(rows * GRID_W)
    row = (t // GRID_W).astype(jnp.float32)
    col = (t % GRID_W).astype(jnp.float32)
    ang = jnp.concatenate([row[:, None] * inv_freq, col[:, None] * inv_freq], axis=-1)
    return jnp.cos(ang), jnp.sin(ang)


def apply_rope(t, cos, sin):
    half = t.shape[-1] // 2
    t1, t2 = t[..., :half], t[..., half:]
    cs = cos[:, None, None, :].astype(t.dtype)
    sn = sin[:, None, None, :].astype(t.dtype)
    return jnp.concatenate([t1 * cs - t2 * sn, t2 * cs + t1 * sn], axis=-1)


def diff_softmax_mix(q, k, v, lam):
    s = jnp.einsum('bqhmd,bkhmd->bhmqk', q, k).astype(jnp.float32) * (DIFF_HEAD_DIM ** -0.5)
    p = jax.nn.softmax(s, axis=-1)
    a = p[:, :, 0] - lam * p[:, :, 1]
    return jnp.einsum('bhqk,bkhe->bqhe', a.astype(v.dtype), v)


def diff_attend_blocks(q, k, v, lam):
    b, t = q.shape[0], q.shape[1]
    nb = t // Q_BLOCK
    qb = jnp.swapaxes(q.reshape((b, nb, Q_BLOCK) + q.shape[2:]), 0, 1)
    ob = lax.map(lambda qq: diff_softmax_mix(qq, k, v, lam), qb)
    return jnp.swapaxes(ob, 0, 1).reshape((b, t) + ob.shape[3:])


def diff_attention_mixer(q_l, k_l, v_l, q_c, k_c, v_c, q_gain, k_gain, lam_vecs, out_gain, lam_init, cos, sin, with_ctx):
    def split_heads(t, g):
        t = t.reshape(t.shape[0], t.shape[1], N_DIFF_HEADS, 2, DIFF_HEAD_DIM)
        return rms_norm(t) * g

    def values(t):
        return t.reshape(t.shape[0], t.shape[1], N_DIFF_HEADS, DIFF_V_DIM)

    def finish(o):
        o = rms_norm(o) * out_gain * (1.0 - lam_init)
        return o.reshape(o.shape[0], o.shape[1], ATTN_V)

    lv = lam_vecs.astype(jnp.float32)
    lam = jnp.exp(jnp.sum(lv[0] * lv[1])) - jnp.exp(jnp.sum(lv[2] * lv[3])) + lam_init
    ql = apply_rope(split_heads(q_l, q_gain), cos, sin)
    kl = apply_rope(split_heads(k_l, k_gain), cos, sin)
    kc = split_heads(k_c, k_gain)
    vl, vc = values(v_l), values(v_c)
    k_all = jnp.concatenate([kc, kl], axis=1)
    v_all = jnp.concatenate([vc, vl], axis=1)
    y_l = finish(diff_attend_blocks(ql, k_all, v_all, lam))
    y_c = None
    if with_ctx:
        y_c = finish(diff_softmax_mix(split_heads(q_c, q_gain), kc, vc, lam))
    return y_l, y_c


def s5_discretize(lam_re, lam_im, log_step, b_re, b_im):
    dt = jnp.exp(log_step)[:, None]
    mag = jnp.exp(lam_re * dt)
    ab_re = mag * jnp.cos(lam_im * dt)
    ab_im = mag * jnp.sin(lam_im * dt)
    nr, ni = ab_re - 1.0, ab_im
    den = lam_re * lam_re + lam_im * lam_im
    f_re = (nr * lam_re + ni * lam_im) / den
    f_im = (ni * lam_re - nr * lam_im) / den
    bb_re = f_re[..., None] * b_re - f_im[..., None] * b_im
    bb_im = f_re[..., None] * b_im + f_im[..., None] * b_re
    return ab_re, ab_im, bb_re, bb_im


def complex_affine_combine(e1, e2):
    a1r, a1i, b1r, b1i = e1
    a2r, a2i, b2r, b2i = e2
    return (a2r * a1r - a2i * a1i,
            a2r * a1i + a2i * a1r,
            a2r * b1r - a2i * b1i + b2r,
            a2r * b1i + a2i * b1r + b2i)


def s5_states(u, ab_re, ab_im, bb_re, bb_im, h0):
    bu_re = jnp.einsum('gph,btgh->btgp', bb_re, u)
    bu_im = jnp.einsum('gph,btgh->btgp', bb_im, u)
    a_re = jnp.broadcast_to(ab_re, bu_re.shape)
    a_im = jnp.broadcast_to(ab_im, bu_im.shape)
    acc_re, acc_im, s_re, s_im = lax.associative_scan(complex_affine_combine, (a_re, a_im, bu_re, bu_im), axis=1)
    if h0 is not None:
        h_re, h_im = h0[0][:, None], h0[1][:, None]
        s_re = s_re + acc_re * h_re - acc_im * h_im
        s_im = s_im + acc_re * h_im + acc_im * h_re
    return s_re, s_im


def s5_readout(s_re, s_im, c_re, c_im):
    return jnp.einsum('ghp,btgp->btgh', c_re, s_re) - jnp.einsum('ghp,btgp->btgh', c_im, s_im)


def s5_mixer(u_l, u_c, lam_re, lam_im, log_step, b_re, b_im, c_re, c_im, d, w_glu, with_ctx):
    b, t, _ = u_l.shape
    ul = u_l.reshape(b, t, S5_GROUPS, S5_GROUP)
    uc = u_c.reshape(b, u_c.shape[1], S5_GROUPS, S5_GROUP)
    dg = d.reshape(S5_GROUPS, S5_GROUP)
    y_l = dg * ul
    y_c = dg * uc if with_ctx else None
    for di in range(2):
        rev = (lambda a: jnp.flip(a, axis=1)) if di == 1 else (lambda a: a)
        disc = s5_discretize(lam_re[di], lam_im[di], log_step[di], b_re[di], b_im[di])
        sc_re, sc_im = s5_states(rev(uc), *disc, None)
        sl_re, sl_im = s5_states(rev(ul), *disc, (sc_re[:, -1], sc_im[:, -1]))
        y_l = y_l + rev(s5_readout(sl_re, sl_im, c_re[di], c_im[di]))
        if with_ctx:
            y_c = y_c + rev(s5_readout(sc_re, sc_im, c_re[di], c_im[di]))

    def glu(y):
        g = jax.nn.gelu(y.reshape(y.shape[0], y.shape[1], S5_WIDTH))
        return g * jax.nn.sigmoid(g @ w_glu)

    return glu(y_l), (glu(y_c) if with_ctx else None)


def short_conv(t, w, bias):
    y = lax.conv_general_dilated(t, w[:, None, :].astype(t.dtype), (1,), 'SAME',
                                 dimension_numbers=('NWC', 'WIO', 'NWC'),
                                 feature_group_count=t.shape[-1])
    return jax.nn.silu(y + bias)


def mlstm_prepare(q, k, v, gates, conv_w, conv_b, i_bias, f_bias, need_q):
    b, t, _ = k.shape

    def heads(a):
        return a.reshape(b, t, MLSTM_HEADS, MLSTM_HEAD_DIM).transpose(0, 2, 1, 3)

    kh = heads(short_conv(k, conv_w[:, MLSTM_WIDTH:], conv_b[MLSTM_WIDTH:])) * (MLSTM_HEAD_DIM ** -0.5)
    qh = heads(short_conv(q, conv_w[:, :MLSTM_WIDTH], conv_b[:MLSTM_WIDTH])) if need_q else None
    g = gates.astype(jnp.float32).reshape(b, t, 2, 2, MLSTM_HEADS)
    ig = (g[:, :, :, 0] + i_bias).transpose(2, 0, 3, 1)
    logf = jax.nn.log_sigmoid(g[:, :, :, 1] + f_bias).transpose(2, 0, 3, 1)
    return qh, kh, heads(v), ig, logf


def mlstm_chunked(q, k, v, ig, logf, state, return_h):
    b, h, t, dh = k.shape
    nc = t // MLSTM_CHUNK
    kc = k.reshape(b, h, nc, MLSTM_CHUNK, dh)
    vc = v.reshape(b, h, nc, MLSTM_CHUNK, dh)
    ig = ig.reshape(b, h, nc, MLSTM_CHUNK)
    cum = jnp.cumsum(logf.reshape(b, h, nc, MLSTM_CHUNK), axis=-1)
    g = cum[..., -1]
    w = g[..., None] - cum + ig
    mw = jnp.max(w, axis=-1)
    ew = jnp.exp(w - mw[..., None])
    kv = jnp.einsum('bhcs,bhcsv,bhcsk->bhcvk', ew, vc, kc)
    ks = jnp.einsum('bhcs,bhcsk->bhck', ew, kc)

    def step(carry, inp):
        c_s, n_s, m_s = carry
        g_c, mw_c, kv_c, ks_c = inp
        m_new = jnp.maximum(g_c + m_s, mw_c)
        a = jnp.exp(g_c + m_s - m_new)
        e = jnp.exp(mw_c - m_new)
        c_new = a[..., None, None] * c_s + e[..., None, None] * kv_c
        n_new = a[..., None] * n_s + e[..., None] * ks_c
        return (c_new, n_new, m_new), (c_s, n_s, m_s)

    first = lambda a: jnp.moveaxis(a, 2, 0)
    final, (c0, n0, m0) = lax.scan(step, state, (first(g), first(mw), first(kv), first(ks)))
    if not return_h:
        return final, None
    c0 = jnp.moveaxis(c0, 0, 2)
    n0 = jnp.moveaxis(n0, 0, 2)
    m0 = jnp.moveaxis(m0, 0, 2)
    qc = q.reshape(b, h, nc, MLSTM_CHUNK, dh)
    lower = jnp.tril(jnp.ones((MLSTM_CHUNK, MLSTM_CHUNK), dtype=bool))
    dmat = cum[..., :, None] - cum[..., None, :] + ig[..., None, :]
    dmat = jnp.where(lower, dmat, -jnp.inf)
    inter = cum + m0[..., None]
    m_t = jnp.maximum(inter, jnp.max(dmat, axis=-1))
    pm = jnp.exp(dmat - m_t[..., None])
    ei = jnp.exp(inter - m_t)
    wq = pm * jnp.einsum('bhctd,bhcsd->bhcts', qc, kc)
    num = jnp.einsum('bhcts,bhcsv->bhctv', wq, vc) + ei[..., None] * jnp.einsum('bhcvk,bhctk->bhctv', c0, qc)
    den = jnp.sum(wq, axis=-1) + ei * jnp.einsum('bhck,bhctk->bhct', n0, qc)
    hout = num / jnp.maximum(jnp.abs(den), jnp.exp(-m_t))[..., None]
    return final, hout.reshape(b, h, t, dh)


def mlstm_mixer(lat, ctx_parts, conv_w, conv_b, i_bias, f_bias, with_ctx):
    q_l, k_l, v_l, o_l, g_l = lat
    q_c, k_c, v_c, o_c, g_c = ctx_parts
    ql, kl, vl, igl, lfl = mlstm_prepare(q_l, k_l, v_l, g_l, conv_w, conv_b, i_bias, f_bias, True)
    qc, kc, vc, igc, lfc = mlstm_prepare(q_c, k_c, v_c, g_c, conv_w, conv_b, i_bias, f_bias, with_ctx)
    b = kl.shape[0]
    zero = (jnp.zeros((b, MLSTM_HEADS, MLSTM_HEAD_DIM, MLSTM_HEAD_DIM), jnp.float32),
            jnp.zeros((b, MLSTM_HEADS, MLSTM_HEAD_DIM), jnp.float32),
            jnp.zeros((b, MLSTM_HEADS), jnp.float32))
    hs_l, hs_c = [], []
    for di in range(2):
        rev = (lambda a: jnp.flip(a, axis=2)) if di == 1 else (lambda a: a)
        q_in = rev(qc) if with_ctx else None
        st, hc = mlstm_chunked(q_in, rev(kc), rev(vc), rev(igc[di]), rev(lfc[di]), zero, with_ctx)
        _, hl = mlstm_chunked(rev(ql), rev(kl), rev(vl), rev(igl[di]), rev(lfl[di]), st, True)
        hs_l.append(rev(hl))
        if with_ctx:
            hs_c.append(rev(hc))

    def out(hs, o):
        hsum = hs[0] + hs[1]
        bb, hh, tt, dd = hsum.shape
        return (hsum.transpose(0, 2, 1, 3).reshape(bb, tt, MLSTM_WIDTH) * jax.nn.sigmoid(o)).astype(o.dtype)

    return out(hs_l, o_l), (out(hs_c, o_c) if with_ctx else None)


def merge_branches(ya, yb, yc, gate_pre, w_branch_l, w_out_l):
    ga, gb, gc = jnp.split(jax.nn.sigmoid(gate_pre), N_BRANCH, axis=-1)
    mixed = ga * (ya @ w_branch_l[0]) + gb * (yb @ w_branch_l[1]) + gc * (yc @ w_branch_l[2])
    return mixed @ w_out_l


def expert_choice_ffn(h, w_router, w_gate, w_up, w_down):
    b, n, _ = h.shape
    cap = CAPACITY_FACTOR * n // N_EXPERTS
    aff = jax.nn.softmax((h @ w_router).astype(jnp.float32), axis=-1)
    top_aff, top_idx = lax.top_k(jnp.swapaxes(aff, 1, 2), cap)
    bidx = jnp.arange(b)[:, None, None]
    xs = h[bidx, top_idx]
    hid = jax.nn.silu(jnp.einsum('becd,edf->becf', xs, w_gate)) * jnp.einsum('becd,edf->becf', xs, w_up)
    ys = jnp.einsum('becf,efd->becd', hid, w_down) * top_aff[..., None].astype(h.dtype)
    return jnp.zeros_like(h).at[bidx, top_idx].add(ys.astype(h.dtype))


def setup_inputs(seed: int = 0) -> dict:
    key = jax.random.key(seed)
    keys = iter(jax.random.split(key, 40))

    def normal(shape, scale):
        return jax.random.normal(next(keys), shape, jnp.float32) * scale

    def uniform(shape, lo, hi):
        return jax.random.uniform(next(keys), shape, jnp.float32, lo, hi)

    L = DEPTH
    G, P, Hg = S5_GROUPS, S5_STATE, S5_GROUP
    n_idx = jnp.arange(P, dtype=jnp.float32)
    return {
        'x': normal((BATCH, SEQ, D_MODEL), 1.0),
        'c': normal((BATCH, D_MODEL), 1.0),
        'ctx': normal((BATCH, CTX_LEN, D_MODEL), 1.0),
        'c_ctx': normal((D_MODEL,), 1.0),
        'w_mod': normal((L, D_MODEL, N_MOD * D_MODEL), 0.5 * D_MODEL ** -0.5),
        'b_mod': normal((L, N_MOD * D_MODEL), 0.02),
        'w_in': normal((L, D_MODEL, D_IN), D_MODEL ** -0.5),
        'attn_q_gain': 1.0 + normal((L, DIFF_HEAD_DIM), 0.02),
        'attn_k_gain': 1.0 + normal((L, DIFF_HEAD_DIM), 0.02),
        'attn_lambda': normal((L, 4, DIFF_HEAD_DIM), 0.1),
        'attn_out_gain': 1.0 + normal((L, DIFF_V_DIM), 0.02),
        's5_lam_re': -0.5 + normal((L, 2, G, P), 0.01),
        's5_lam_im': math.pi * n_idx + normal((L, 2, G, P), 0.01),
        's5_log_step': uniform((L, 2, G), math.log(1e-3), math.log(1e-1)),
        's5_b_re': normal((L, 2, G, P, Hg), (2.0 * Hg) ** -0.5),
        's5_b_im': normal((L, 2, G, P, Hg), (2.0 * Hg) ** -0.5),
        's5_c_re': normal((L, 2, G, Hg, P), (2.0 * P) ** -0.5),
        's5_c_im': normal((L, 2, G, Hg, P), (2.0 * P) ** -0.5),
        's5_d': normal((L, S5_WIDTH), 1.0),
        's5_w_glu': normal((L, S5_WIDTH, S5_WIDTH), S5_WIDTH ** -0.5),
        'mlstm_conv_w': normal((L, CONV_K, 2 * MLSTM_WIDTH), CONV_K ** -0.5),
        'mlstm_conv_b': normal((L, 2 * MLSTM_WIDTH), 0.02),
        'mlstm_i_bias': normal((L, 2, MLSTM_HEADS), 0.1),
        'mlstm_f_bias': uniform((L, 2, MLSTM_HEADS), 3.0, 6.0),
        'w_branch': normal((L, N_BRANCH, BRANCH_WIDTH, D_MODEL), BRANCH_WIDTH ** -0.5),
        'w_out': normal((L, D_MODEL, D_MODEL), D_MODEL ** -0.5),
        'w_router': normal((L, D_MODEL, N_EXPERTS), D_MODEL ** -0.5),
        'w_exp_gate': normal((L, N_EXPERTS, D_MODEL, D_EXPERT), D_MODEL ** -0.5),
        'w_exp_up': normal((L, N_EXPERTS, D_MODEL, D_EXPERT), D_MODEL ** -0.5),
        'w_exp_down': normal((L, N_EXPERTS, D_EXPERT, D_MODEL), D_EXPERT ** -0.5),
    }


def reference(x, c, ctx, c_ctx, w_mod, b_mod, w_in, attn_q_gain, attn_k_gain, attn_lambda, attn_out_gain,
              s5_lam_re, s5_lam_im, s5_log_step, s5_b_re, s5_b_im, s5_c_re, s5_c_im, s5_d, s5_w_glu,
              mlstm_conv_w, mlstm_conv_b, mlstm_i_bias, mlstm_f_bias,
              w_branch, w_out, w_router, w_exp_gate, w_exp_up, w_exp_down):
    n_lat = x.shape[1]
    ROWS = n_lat // GRID_W
    cos, sin = axial_rope_tables(ROWS)
    silu_c = jax.nn.silu(c)[:, None, :]
    silu_cc = jax.nn.silu(c_ctx)
    xc = ctx
    for l in range(DEPTH):
        with_ctx = l != DEPTH - 1
        mod_l = jnp.split(silu_c @ w_mod[l] + b_mod[l], N_MOD, axis=-1)
        mod_c = jnp.split(silu_cc @ w_mod[l] + b_mod[l], N_MOD, axis=-1)
        lam_init = 0.8 - 0.6 * math.exp(-0.3 * l)
        pl = split_projection(modulate(x, mod_l[0], mod_l[1]) @ w_in[l])
        pc = split_projection(modulate(xc, mod_c[0], mod_c[1]) @ w_in[l])
        ya_l, ya_c = diff_attention_mixer(pl[0], pl[1], pl[2], pc[0], pc[1], pc[2],
                                          attn_q_gain[l], attn_k_gain[l], attn_lambda[l], attn_out_gain[l],
                                          lam_init, cos, sin, with_ctx)
        yb_l, yb_c = s5_mixer(pl[3], pc[3], s5_lam_re[l], s5_lam_im[l], s5_log_step[l], s5_b_re[l], s5_b_im[l],
                              s5_c_re[l], s5_c_im[l], s5_d[l], s5_w_glu[l], with_ctx)
        yc_l, yc_c = mlstm_mixer(pl[4:9], pc[4:9], mlstm_conv_w[l], mlstm_conv_b[l],
                                 mlstm_i_bias[l], mlstm_f_bias[l], with_ctx)
        x = x + mod_l[2] * merge_branches(ya_l, yb_l, yc_l, pl[9], w_branch[l], w_out[l])
        x = x + mod_l[5] * expert_choice_ffn(modulate(x, mod_l[3], mod_l[4]),
                                             w_router[l], w_exp_gate[l], w_exp_up[l], w_exp_down[l])
        if with_ctx:
            xc = xc + mod_c[2] * merge_branches(ya_c, yb_c, yc_c, pc[9], w_branch[l], w_out[l])
            xc = xc + mod_c[5] * expert_choice_ffn(modulate(xc, mod_c[3], mod_c[4]),
                                                   w_router[l], w_exp_gate[l], w_exp_up[l], w_exp_down[l])
    return x
```

```cpp
#include <hip/hip_runtime.h>
#ifndef EMU
#include <cstdio>
#include <cstdint>
#endif

#ifndef CFG_D
#define CFG_D 1024
#define CFG_SEQ 16384
#define CFG_DEPTH 4
#define CFG_CTX 256
#define CFG_DE 2048
#define CFG_MOE_BM 256
#endif
#ifndef PROBE_MASK
#define PROBE_MASK 0u
#endif
#ifndef PROBE_SUB
#define PROBE_SUB 0
#endif
#ifndef SCHED_MODE
#define SCHED_MODE 1
#endif
#ifndef MK_FUSED
#define MK_FUSED 1
#endif
constexpr int D = CFG_D, NB = 2, T = CFG_SEQ, TC = CFG_CTX, NL = CFG_DEPTH, DE = CFG_DE, NE = 16;
constexpr int RL = NB * T, RC = NB * TC, R = RL + RC;
constexpr int TK = TC + T;
constexpr int DIN = 4112 + 3 * D;
constexpr int LDP = 4096 + 3 * D;
constexpr int NPIN = ((LDP + 16 + 255) / 256) * 256;
constexpr int NTHR = 512;
constexpr float EPS = 1e-6f;
constexpr int S5L = 64, NCH = NB * TK / S5L, NCHB = TK / S5L;
constexpr int MLC = 128, NCM = TK / MLC, NCMC = TC / MLC;
constexpr int CAPL = 2 * T / NE, CAPC = 2 * TC / NE;
constexpr int MOE_BM = CFG_MOE_BM;
constexpr int MEL = NB * CAPL, MEC = NB * CAPC;
constexpr int MEP = MEL + 64 * ((MEC + 63) / 64);
static_assert(R % 256 == 0 && T % 256 == 0 && TC % 256 == 0 && D % 256 == 0 && DE % 256 == 0, "tile divisibility");
static_assert(MEL % MOE_BM == 0, "moe tile");

typedef unsigned short bf16_t;
typedef short bf16x8 __attribute__((ext_vector_type(8)));
typedef float f32x16 __attribute__((ext_vector_type(16)));
typedef float f32x4 __attribute__((ext_vector_type(4)));
typedef unsigned u32x4 __attribute__((ext_vector_type(4)));
typedef unsigned u32x2 __attribute__((ext_vector_type(2)));
#define DEV __device__ __forceinline__
#ifdef EMU
#define LDSQ
#else
#define LDSQ __attribute__((address_space(3)))
#endif
typedef LDSQ unsigned char* lds_t;
#ifdef EMU
#define TIDX ((int)threadIdx.x)
#else
__device__ __forceinline__ int opaque_tid() { int t = threadIdx.x; asm volatile("" : "+v"(t)); return t; }
#define TIDX opaque_tid()
#endif

enum { I_X, I_C, I_CTX, I_CCTX, I_WMOD, I_BMOD, I_WIN, I_QG, I_KG, I_LAMV, I_OG, I_S5LRE, I_S5LIM, I_S5STEP, I_S5BRE, I_S5BIM, I_S5CRE, I_S5CIM,
       I_S5D, I_S5GLU, I_CONVW, I_CONVB, I_IB, I_FB, I_WBR, I_WOUT, I_WR, I_WEG, I_WEU, I_WED, N_IN };
struct Params { const float* in[N_IN]; float* out; unsigned char* ws; };

constexpr size_t ws_al(size_t x) { return (x + 255) & ~size_t(255); }
struct WS {
    static constexpr size_t BAR = 0,                         BAR_SZ = ws_al(4096 * 4);
    static constexpr size_t MODV = BAR + BAR_SZ,             MODV_SZ = ws_al((size_t)NL * 3 * 6 * D * 4);
    static constexpr size_t ROPE = MODV + MODV_SZ,           ROPE_SZ = ws_al((size_t)(T / 64 + 64) * 16 * 2 * 4);
    static constexpr size_t XCUR = ROPE + ROPE_SZ,           XCUR_SZ = ws_al((size_t)R * D * 4);
    static constexpr size_t A1 = XCUR + XCUR_SZ,             A1_SZ = ws_al((size_t)R * D * 2);
    static constexpr size_t WIN = A1 + A1_SZ,                WIN_SZ = ws_al((size_t)NPIN * D * 2);
    static constexpr size_t WGLU = WIN + WIN_SZ,             WGLU_SZ = ws_al((size_t)512 * 512 * 2);
    static constexpr size_t WBR = WGLU + WGLU_SZ,            WBR_SZ = ws_al((size_t)3 * D * 512 * 2);
    static constexpr size_t WOUT = WBR + WBR_SZ,             WOUT_SZ = ws_al((size_t)D * D * 2);
    static constexpr size_t WGU = WOUT + WOUT_SZ,            WGU_SZ = ws_al((size_t)NE * 2 * DE * D * 2);
    static constexpr size_t WDN = WGU + WGU_SZ,              WDN_SZ = ws_al((size_t)NE * D * DE * 2);
    static constexpr size_t WSET = WIN_SZ + WGLU_SZ + WBR_SZ + WOUT_SZ + WGU_SZ + WDN_SZ;
    static constexpr size_t GATES = WDN + WDN_SZ + WSET,            GATES_SZ = ws_al((size_t)R * 16 * 4);
    static constexpr size_t QP = GATES + GATES_SZ,           QP_SZ = ws_al((size_t)NB * 4 * TK * 128 * 2);
    static constexpr size_t KP = QP + QP_SZ,                 KP_SZ = QP_SZ;
    static constexpr size_t VT = KP + KP_SZ,                 VT_SZ = QP_SZ;
    static constexpr size_t YA = VT + VT_SZ,                 Y_SZ = ws_al((size_t)R * 512 * 2);
    static constexpr size_t YB = YA + Y_SZ;
    static constexpr size_t YC = YB + Y_SZ;
    static constexpr size_t YG = YC + Y_SZ;
    static constexpr size_t MIXED = YG + Y_SZ,               MIXED_SZ = ws_al((size_t)R * D * 2);
    static constexpr size_t UG = MIXED + MIXED_SZ,           UG_SZ = ws_al((size_t)32 * NCH * 1280 * 2);
    static constexpr size_t SLOC = UG + UG_SZ,               SLOC_SZ = ws_al((size_t)32 * NCH * 256 * 4);
    static constexpr size_t S5MIN = SLOC + SLOC_SZ,          S5MIN_SZ = ws_al((size_t)32 * 256 * 1024 * 2);
    static constexpr size_t S5TOEP = S5MIN + S5MIN_SZ,       S5TOEP_SZ = ws_al((size_t)32 * 1024 * 1280 * 2);
    static constexpr size_t S5A64 = S5TOEP + S5TOEP_SZ,      S5A64_SZ = ws_al((size_t)2 * 2 * 32 * 64 * 2 * 4);
    static constexpr size_t S5KT = S5A64 + S5A64_SZ,         S5KT_SZ = ws_al((size_t)32 * 2 * 64 * 256 * 4);
    static constexpr size_t MQ = S5KT + S5KT_SZ,             MQ_SZ = ws_al((size_t)NB * 4 * TK * 128 * 2);
    static constexpr size_t MK = MQ + MQ_SZ;
    static constexpr size_t MKT = MK + MQ_SZ;
    static constexpr size_t MVT = MKT + MQ_SZ;
    static constexpr size_t MIG = MVT + MQ_SZ,               MIG_SZ = ws_al((size_t)2 * NB * 4 * TK * 4);
    static constexpr size_t MLF = MIG + MIG_SZ;
    static constexpr size_t MKV = MLF + MIG_SZ,              MKV_SZ = ws_al((size_t)2 * NB * 4 * NCM * 128 * 128 * 4);
    static constexpr size_t MKS = MKV + MKV_SZ,              MKS_SZ = ws_al((size_t)2 * NB * 4 * NCM * 128 * 4);
    static constexpr size_t MGM = MKS + MKS_SZ,              MGM_SZ = ws_al((size_t)2 * NB * 4 * NCM * 4 * 4);
    static constexpr size_t MC0 = MGM + MGM_SZ,              MC0_SZ = ws_al((size_t)2 * NB * 4 * NCM * 128 * 128 * 2);
    static constexpr size_t MN0 = MC0 + MC0_SZ,              MN0_SZ = MKS_SZ;
    static constexpr size_t AFF = MN0 + MN0_SZ,              AFF_SZ = ws_al((size_t)NB * NE * TK * 4);
    static constexpr size_t SELROW = AFF + AFF_SZ,           SEL_SZ = ws_al((size_t)NE * MEP * 4);
    static constexpr size_t SELAFF = SELROW + SEL_SZ;
    static constexpr size_t TOKSLOT = SELAFF + SEL_SZ,       TOKSLOT_SZ = ws_al((size_t)R * NE * 4);
    static constexpr size_t PBUF = TOKSLOT + TOKSLOT_SZ,     PBUF_SZ = ws_al((size_t)R * LDP * 2);
    static constexpr size_t HID = PBUF,                      HID_SZ = ws_al((size_t)NE * MEP * DE * 2);
    static constexpr size_t YS = HID + HID_SZ,               YS_SZ = ws_al((size_t)NE * MEP * D * 2);
    static constexpr size_t END0 = PBUF + PBUF_SZ, END1 = YS + YS_SZ;
    static constexpr size_t TOTAL = END0 > END1 ? END0 : END1;
};

DEV float bf2f(bf16_t v) { return __uint_as_float(((unsigned)v) << 16); }
DEV bf16_t f2bf(float f) { unsigned u = __float_as_uint(f); u += 0x7fffu + ((u >> 16) & 1u); return (bf16_t)(u >> 16); }
DEV unsigned pack2(float lo, float hi) {
#ifdef EMU
    return (unsigned)f2bf(lo) | ((unsigned)f2bf(hi) << 16);
#else
    unsigned r; asm("v_cvt_pk_bf16_f32 %0, %1, %2" : "=v"(r) : "v"(lo), "v"(hi)); return r;
#endif
}
DEV float fexp2(float x) {
#ifdef EMU
    return exp2f(x);
#else
    return __builtin_amdgcn_exp2f(x);
#endif
}
DEV float fexp(float x) { return fexp2(x * 1.44269504089f); }
DEV float frcp(float x) {
#ifdef EMU
    return 1.0f / x;
#else
    return __builtin_amdgcn_rcpf(x);
#endif
}
DEV float sigmoidf_(float x) { return frcp(1.0f + fexp(-x)); }
DEV float siluf_(float x) { return x * sigmoidf_(x); }
DEV float wave_sum(float v) { v += __shfl_xor(v, 1); v += __shfl_xor(v, 2); v += __shfl_xor(v, 4); v += __shfl_xor(v, 8); v += __shfl_xor(v, 16); v += __shfl_xor(v, 32); return v; }
DEV float wave_max(float v) { v = fmaxf(v, __shfl_xor(v, 1)); v = fmaxf(v, __shfl_xor(v, 2)); v = fmaxf(v, __shfl_xor(v, 4)); v = fmaxf(v, __shfl_xor(v, 8)); v = fmaxf(v, __shfl_xor(v, 16)); v = fmaxf(v, __shfl_xor(v, 32)); return v; }

DEV f32x16 mfma32(bf16x8 a, bf16x8 b, f32x16 c) {
#ifdef EMU
    struct { bf16x8 a, b; } mine{a, b};
    const unsigned char* base = emu_wave_exchange(&mine, 32);
    const int l = emu_lane(), col = l & 31, h = l >> 5;
    for (int r = 0; r < 16; ++r) {
        const int i = (r & 3) + 8 * (r >> 2) + 4 * h; float s = c[r];
        for (int hh = 0; hh < 2; ++hh) {
            bf16x8 av, bv; memcpy(&av, base + 256 * (i + 32 * hh), 16); memcpy(&bv, base + 256 * (col + 32 * hh) + 16, 16);
            for (int e = 0; e < 8; ++e) s += bf2f((bf16_t)av[e]) * bf2f((bf16_t)bv[e]);
        }
        c[r] = s;
    }
    return c;
#else
    return __builtin_amdgcn_mfma_f32_32x32x16_bf16(a, b, c, 0, 0, 0);
#endif
}
DEV f32x4 mfma16(bf16x8 a, bf16x8 b, f32x4 c) {
#ifdef EMU
    struct { bf16x8 a, b; } mine{a, b};
    const unsigned char* base = emu_wave_exchange(&mine, 32);
    const int l = emu_lane(), col = l & 15, q = l >> 4;
    for (int r = 0; r < 4; ++r) {
        const int i = 4 * q + r; float s = c[r];
        for (int kq = 0; kq < 4; ++kq) {
            bf16x8 av, bv; memcpy(&av, base + 256 * (i + 16 * kq), 16); memcpy(&bv, base + 256 * (col + 16 * kq) + 16, 16);
            for (int e = 0; e < 8; ++e) s += bf2f((bf16_t)av[e]) * bf2f((bf16_t)bv[e]);
        }
        c[r] = s;
    }
    return c;
#else
    return __builtin_amdgcn_mfma_f32_16x16x32_bf16(a, b, c, 0, 0, 0);
#endif
}
DEV void lds_inc(LDSQ unsigned* p) {
#ifdef EMU
    *p += 1u;
#else
    __hip_atomic_fetch_add(p, 1u, __ATOMIC_RELAXED, __HIP_MEMORY_SCOPE_WORKGROUP);
#endif
}
DEV u32x4 ldg16(const void* p) { return *(const u32x4*)p; }
#ifdef EMU
typedef const bf16_t* gbf_t;
#else
typedef const __attribute__((address_space(1))) bf16_t* gbf_t;
#endif
DEV u32x4 ldg16g(gbf_t p) {
#ifdef EMU
    return *(const u32x4*)p;
#else
    return *(const __attribute__((address_space(1))) u32x4*)p;
#endif
}
DEV u32x4 lds_ld16(lds_t p) { return *(LDSQ const u32x4*)p; }
DEV void lds_st16(lds_t p, u32x4 v) { *(LDSQ u32x4*)p = v; }
DEV bf16x8 as_bf8(u32x4 v) { bf16x8 r; __builtin_memcpy(&r, &v, 16); return r; }

#ifndef EMU
#define XB_TMO      128
#define XB_XCNT(j)  (256  + 64 * (j))
#define XB_XSUB(j)  (1280 + 64 * (j))
#define XB_XGEN(j)  (2304 + 64 * (j))
#define XB_TOP      3328
#define XB_TOPGEN   3392
#define XCD_BAR_WORDS 3456
#define XB_SPIN_CAP (1u << 24)
#define LAS __attribute__((address_space(3)))
__device__ __forceinline__ unsigned xb_ld(unsigned* p)              { return __hip_atomic_load(p, __ATOMIC_RELAXED, __HIP_MEMORY_SCOPE_AGENT); }
__device__ __forceinline__ unsigned xb_add(unsigned* p, unsigned v) { return __hip_atomic_fetch_add(p, v, __ATOMIC_RELAXED, __HIP_MEMORY_SCOPE_AGENT); }
__device__ __forceinline__ unsigned xb_xcc_id() { return (unsigned)__builtin_amdgcn_s_getreg((3 << 11) | 20) & 0xFu; }
#define XB_SPIN(cond, bar) do { unsigned _sp = 0; while (cond) { __builtin_amdgcn_s_sleep(1); \
    if ((++_sp & 255u) == 0u) { if (xb_ld(&(bar)[XB_TMO])) break; if (_sp > XB_SPIN_CAP) { atomicAdd(&(bar)[XB_TMO], 1u); break; } } } } while (0)
struct XcdBarrier { unsigned* bar; unsigned x; volatile LAS unsigned* st; };
__device__ __forceinline__ XcdBarrier xcd_barrier_post(unsigned* bar, volatile LAS unsigned* st) {
    XcdBarrier b; b.bar = bar; b.x = xb_xcc_id(); b.st = st;
    if (threadIdx.x == 0) (void)xb_add(&bar[XB_XCNT(b.x)], 1u);
    return b;
}
__device__ __forceinline__ void xcd_barrier_complete(unsigned* bar, unsigned x, unsigned& nloc, unsigned& nx) {
    const unsigned G = gridDim.x * gridDim.y * gridDim.z;
    unsigned sum, cnt, mine, sp = 0u;
    for (;;) {
        sum = 0u; cnt = 0u; mine = 0u;
#pragma unroll
        for (unsigned j = 0; j < 16; ++j) { const unsigned c = xb_ld(&bar[XB_XCNT(j)]); sum += c; cnt += (c > 0u) ? 1u : 0u; mine = (j == x) ? c : mine; }
        if (sum == G) break;
        __builtin_amdgcn_s_sleep(1);
        if ((++sp & 255u) == 0u) { if (xb_ld(&bar[XB_TMO])) break; if (sp > XB_SPIN_CAP) { atomicAdd(&bar[XB_TMO], 1u); break; } }
    }
    nloc = mine > 0u ? mine : 1u; nx = cnt > 0u ? cnt : 1u;
}
__device__ __forceinline__ void xcd_barrier(const XcdBarrier& b) {
    asm volatile("s_waitcnt vmcnt(0)" ::: "memory");
    __syncthreads();
    if (threadIdx.x == 0) {
        unsigned* bar = b.bar;
        __builtin_amdgcn_s_waitcnt(0);
        unsigned nloc = b.st[0], nx = b.st[1];
        if (nloc == 0u) { xcd_barrier_complete(bar, b.x, nloc, nx); b.st[0] = nloc; b.st[1] = nx; }
        const unsigned old = xb_add(&bar[XB_XSUB(b.x)], 1u);
        const unsigned gen = old / nloc;
        if (old + 1u == (gen + 1u) * nloc) {
            __builtin_amdgcn_fence(__ATOMIC_RELEASE, "agent");
            asm volatile("s_waitcnt vmcnt(0)" ::: "memory");
            const unsigned og = xb_add(&bar[XB_TOP], 1u);
            const unsigned tg = og / nx;
            if (og + 1u == (tg + 1u) * nx) xb_add(&bar[XB_TOPGEN], 1u);
            else XB_SPIN(xb_ld(&bar[XB_TOPGEN]) == tg, bar);
            __builtin_amdgcn_fence(__ATOMIC_ACQUIRE, "agent");
            xb_add(&bar[XB_XGEN(b.x)], 1u);
            asm volatile("s_waitcnt vmcnt(0)" ::: "memory");
        } else {
            XB_SPIN(xb_ld(&bar[XB_XGEN(b.x)]) == gen, bar);
            __builtin_amdgcn_fence(__ATOMIC_ACQUIRE, "agent");
            asm volatile("s_waitcnt vmcnt(0)" ::: "memory");
        }
    }
    __syncthreads();
}
#endif

template <int MT_, int NT_, int WM_, int WN_> struct GT {
    static constexpr int MT = MT_, NT = NT_, WM = WM_, WN = WN_;
    static constexpr int BM = 32 * MT * WM, BN = 32 * NT * WN, MI = 2 * MT, NI = 2 * NT;
    static constexpr int RS = 128, A_BYTES = BM * RS, B_BYTES = BN * RS, STAGE = A_BYTES + B_BYTES, LDS_BYTES = 2 * STAGE;
    static constexpr int ACH = BM / 64, BCH = BN / 64;
    static_assert(WM * WN == 8 && BM % 64 == 0 && BN % 64 == 0, "8 waves, loader rows");
};
typedef GT<2, 4, 4, 2> GBig;
typedef GT<1, 2, 2, 4> GSmall;
typedef GT<2, 2, 4, 2> GMid;

DEV void glds16(const void* g, lds_t wave_base) {
#ifdef EMU
    memcpy(wave_base + 16 * emu_lane(), g, 16);
#else
    __builtin_amdgcn_global_load_lds((const __attribute__((address_space(1))) unsigned*)g, (LDSQ unsigned*)wave_base, 16, 0, 0);
#endif
}
DEV int uniform_i(int v) {
#ifdef EMU
    return v;
#else
    return __builtin_amdgcn_readfirstlane(v);
#endif
}
#ifdef EMU
#define GEMM_SB()
#else
#define GEMM_SB() __builtin_amdgcn_sched_barrier(0)
#endif
template <class G, bool NULLS = false, int KMODE = 0, bool PIPE = true, class AFn>
DEV void gemm_acc(f32x4 (&acc)[G::MI][G::NI], AFn arow, const bf16_t* __restrict__ Bt, size_t ldb, int m0, int n0, int K, lds_t smem) {
    const int tid = TIDX, lane = tid & 63, wave = uniform_i(tid >> 6), wm = wave / G::WN, wn = wave % G::WN;
    const int lr = wave * 8 + (lane >> 3), lc = (lane & 7) ^ ((lr >> 1) & 7);
    const bf16_t* ap[G::ACH];
#pragma unroll
    for (int i = 0; i < G::ACH; ++i) ap[i] = arow(m0 + lr + 64 * i) + lc * 8;
    const bf16_t* bp = Bt + (size_t)(n0 + lr) * ldb + lc * 8;
    const int nk = K / 64;
    auto issue = [&](int kt, int st) {
        lds_t sa = smem + st * G::STAGE + wave * 1024, sb = sa + G::A_BYTES;
        const int ko = KMODE == 1 ? 0 : kt * 64;
#pragma unroll
        for (int i = 0; i < G::ACH; ++i) glds16(ap[i] + ko, sa + i * 8192);
#pragma unroll
        for (int i = 0; i < G::BCH; ++i) glds16(bp + (size_t)(64 * i) * ldb + ko, sb + i * 8192);
    };
    const int r16 = lane & 15, kq = lane >> 4;
    const int xr = (r16 >> 1) & 7, xt = (kq ^ (xr & 3)) * 16, xu = xr >> 2;
    const int aoff = (wm * 32 * G::MT + r16) * 128 + xt, boff = G::A_BYTES + (wn * 32 * G::NT + r16) * 128 + xt;
    constexpr int NH = G::NI / 2;
    issue(0, 0); __syncthreads();
    for (int kt = 0; kt < nk; ++kt) {
        if (kt + 1 < nk && KMODE != 3) issue(kt + 1, (kt + 1) & 1);
        lds_t st = smem + (kt & 1) * G::STAGE;
        if constexpr (!PIPE) {
#pragma unroll
            for (int kh = 0; kh < 2; ++kh) {
                const int ko = (kh ^ xu) * 64;
                bf16x8 a1[G::MI], b1[G::NI];
#pragma unroll
                for (int mi = 0; mi < G::MI; ++mi) a1[mi] = as_bf8(lds_ld16(st + aoff + ko + mi * 2048));
#pragma unroll
                for (int ni = 0; ni < G::NI; ++ni) b1[ni] = as_bf8(lds_ld16(st + boff + ko + ni * 2048));
#pragma unroll
                for (int mi = 0; mi < G::MI; ++mi)
#pragma unroll
                    for (int ni = 0; ni < G::NI; ++ni) acc[mi][ni] = mfma16(b1[ni], a1[mi], acc[mi][ni]);
                GEMM_SB();
            }
        } else {
        bf16x8 af[2][G::MI], bfr[2][NH];
        {
            const int ko = (0 ^ xu) * 64;
#pragma unroll
            for (int mi = 0; mi < G::MI; ++mi) af[0][mi] = as_bf8(lds_ld16(st + aoff + ko + mi * 2048));
#pragma unroll
            for (int j = 0; j < NH; ++j) bfr[0][j] = as_bf8(lds_ld16(st + boff + ko + j * 2048));
        }
#pragma unroll
        for (int sg = 0; sg < 4; ++sg) {
            const int kh = sg >> 1, nh = sg & 1;
            if (sg < 3) {
                const int kh2 = (sg + 1) >> 1, nh2 = (sg + 1) & 1, ko = (kh2 ^ xu) * 64;
                if (nh2 == 0) {
#pragma unroll
                    for (int mi = 0; mi < G::MI; ++mi) af[kh2][mi] = as_bf8(lds_ld16(st + aoff + ko + mi * 2048));
                }
#pragma unroll
                for (int j = 0; j < NH; ++j) bfr[(sg + 1) & 1][j] = as_bf8(lds_ld16(st + boff + ko + (nh2 * NH + j) * 2048));
            }
            GEMM_SB();
#pragma unroll
            for (int mi = 0; mi < G::MI; ++mi)
#pragma unroll
                for (int j = 0; j < NH; ++j) acc[mi][nh * NH + j] = mfma16(bfr[sg & 1][j], af[kh][mi], acc[mi][nh * NH + j]);
            GEMM_SB();
        }
        }
        __syncthreads();
    }
}
template <class G> DEV void zero_acc(f32x4 (&acc)[G::MI][G::NI]) {
#pragma unroll
    for (int mi = 0; mi < G::MI; ++mi)
#pragma unroll
        for (int ni = 0; ni < G::NI; ++ni) acc[mi][ni] = (f32x4){0.f, 0.f, 0.f, 0.f};
}
template <class G, class TF, class ST>
DEV void epi_lds_bf16(const f32x4 (&acc)[G::MI][G::NI], int m0, int n0, lds_t smem, TF tf, ST st) {
    constexpr int RSE = G::BN * 2 + 16;
    const int tid = TIDX, lane = tid & 63, wave = tid >> 6, wm = wave / G::WN, wn = wave % G::WN;
#pragma unroll
    for (int mi = 0; mi < G::MI; ++mi) {
        const int rl = wm * 32 * G::MT + mi * 16 + (lane & 15);
#pragma unroll
        for (int ni = 0; ni < G::NI; ++ni) {
            const int cl = wn * 32 * G::NT + ni * 16 + 4 * (lane >> 4);
            const f32x4 v = tf(m0 + rl, n0 + cl, acc[mi][ni]);
            u32x2 w; w.x = pack2(v[0], v[1]); w.y = pack2(v[2], v[3]);
            *(LDSQ u32x2*)(smem + rl * RSE + cl * 2) = w;
        }
    }
    __syncthreads();
    constexpr int CPR = G::BN / 8;
#pragma unroll 4
    for (int id = tid; id < G::BM * CPR; id += NTHR) { const int rl = id / CPR, cc = id % CPR; st(m0 + rl, n0 + cc * 8, lds_ld16(smem + rl * RSE + cc * 16)); }
    __syncthreads();
}
template <class G, class RM>
DEV void epi_lds_f32(const f32x4 (&acc)[G::MI][G::NI], int m0, int n0, lds_t smem, RM rm) {
    constexpr int RSF = G::BN * 4 + 16;
    static_assert(G::BM * RSF <= 160 * 1024 - 64, "f32 staging tile too large");
    const int tid = TIDX, lane = tid & 63, wave = tid >> 6, wm = wave / G::WN, wn = wave % G::WN;
#pragma unroll
    for (int mi = 0; mi < G::MI; ++mi)
#pragma unroll
        for (int ni = 0; ni < G::NI; ++ni)
            *(LDSQ f32x4*)(smem + (wm * 32 * G::MT + mi * 16 + (lane & 15)) * RSF + (wn * 32 * G::NT + ni * 16 + 4 * (lane >> 4)) * 4) = acc[mi][ni];
    __syncthreads();
    constexpr int CPR = G::BN / 8;
#pragma unroll 2
    for (int id = tid; id < G::BM * CPR; id += NTHR) {
        const int rl = id / CPR, cc = id % CPR;
        rm(m0 + rl, n0 + cc * 8, *(LDSQ const f32x4*)(smem + rl * RSF + cc * 32), *(LDSQ const f32x4*)(smem + rl * RSF + cc * 32 + 16));
    }
    __syncthreads();
}
DEV void unpack8f(u32x4 raw, f32x4& a, f32x4& b) {
    a = (f32x4){__uint_as_float(raw.x << 16), __uint_as_float(raw.x & 0xffff0000u), __uint_as_float(raw.y << 16), __uint_as_float(raw.y & 0xffff0000u)};
    b = (f32x4){__uint_as_float(raw.z << 16), __uint_as_float(raw.z & 0xffff0000u), __uint_as_float(raw.w << 16), __uint_as_float(raw.w & 0xffff0000u)};
}
DEV u32x4 pack8f(f32x4 a, f32x4 b) { u32x4 w; w.x = pack2(a[0], a[1]); w.y = pack2(a[2], a[3]); w.z = pack2(b[0], b[1]); w.w = pack2(b[2], b[3]); return w; }
DEV void st_bf4(bf16_t* p, f32x4 v) { u32x2 w; w.x = pack2(v[0], v[1]); w.y = pack2(v[2], v[3]); *(u32x2*)p = w; }

#ifdef EMU
#define KAS
#else
#define KAS __attribute__((address_space(4)))
#endif
struct Ctx { const KAS Params& p; lds_t smem; int bid, nblk, par; };
DEV int row_cond(int row) { return row < RL ? row / T : 2; }
DEV void row_bpos(int row, int& b, int& pos) { if (row < RL) { b = row / T; pos = TC + row % T; } else { const int rc = row - RL; b = rc / TC; pos = rc % TC; } }
DEV int bpos_row(int b, int pos) { return pos < TC ? RL + b * TC + pos : b * T + (pos - TC); }

constexpr int NCHC = TC / S5L, NCHL = T / S5L, NRL5 = NB * NCHL;
DEV int s5_cr(int b, int j) { return j >= NCHC ? b * NCHL + (j - NCHC) : NRL5 + b * NCHC + j; }
DEV void s5_cr_inv(int row, int& b, int& pos0) { if (row < NRL5) { b = row / NCHL; pos0 = TC + (row % NCHL) * 64; } else { const int r = row - NRL5; b = r / NCHC; pos0 = (r % NCHC) * 64; } }
DEV int perm_slot(int round, int bid, int nblk) { return (nblk & 7) == 0 ? round * nblk + (bid & 7) * (nblk >> 3) + (bid >> 3) : round * nblk + bid; }
DEV void grouped_tile(int w, int NMT, int NNT, int& mt, int& nt) {
    const int nig = 8 * NNT, grp = w / nig, fm = grp * 8, gsz = (NMT - fm) < 8 ? (NMT - fm) : 8, r = w % nig;
    mt = fm + r % gsz; nt = r / gsz;
}
DEV bool tile_order(int round, int bid, int nblk, int NMT, int NNT, int& mt, int& nt) {
    const int slot = perm_slot(round, bid, nblk);
    if (slot >= NMT * NNT) return false;
    grouped_tile(slot, NMT, NNT, mt, nt); return true;
}
DEV void phase_prologue(const Ctx& c) {
    const int tid = TIDX;
    float* modv = (float*)(c.p.ws + WS::MODV);
    {
        LDSQ float* red = (LDSQ float*)c.smem;
        const int nitem = NL * (6 * D / 64);
        for (int it = c.bid; it < nitem; it += c.nblk) {
            const int l = it / (6 * D / 64), j = (it % (6 * D / 64)) * 64 + (tid & 63), ksl = tid >> 6;
            const float* w = c.p.in[I_WMOD] + (size_t)l * D * 6 * D + j;
            float a0 = 0.f, a1 = 0.f, a2 = 0.f;
            for (int k = ksl * (D / 8); k < (ksl + 1) * (D / 8); ++k) {
                const float wv = w[(size_t)k * 6 * D];
                a0 += siluf_(c.p.in[I_C][k]) * wv; a1 += siluf_(c.p.in[I_C][D + k]) * wv; a2 += siluf_(c.p.in[I_CCTX][k]) * wv;
            }
            red[(ksl * 3 + 0) * 64 + (tid & 63)] = a0; red[(ksl * 3 + 1) * 64 + (tid & 63)] = a1; red[(ksl * 3 + 2) * 64 + (tid & 63)] = a2;
            __syncthreads();
            if (tid < 192) {
                const int cond = tid >> 6, jj = tid & 63; float s = 0.f;
                for (int q = 0; q < 8; ++q) s += red[(q * 3 + cond) * 64 + jj];
                const int jc = (it % (6 * D / 64)) * 64 + jj;
                modv[((size_t)l * 3 + cond) * 6 * D + jc] = s + c.p.in[I_BMOD][(size_t)l * 6 * D + jc];
            }
            __syncthreads();
        }
    }
    {
        float* xc = (float*)(c.p.ws + WS::XCUR);
        const size_t n4 = (size_t)R * D / 4, nl4 = (size_t)RL * D / 4;
        for (size_t i = (size_t)c.bid * NTHR + tid; i < n4; i += (size_t)c.nblk * NTHR) {
            f32x4 v = i < nl4 ? ((const f32x4*)c.p.in[I_X])[i] : ((const f32x4*)c.p.in[I_CTX])[i - nl4];
            ((f32x4*)xc)[i] = v;
        }
    }
    {
        float* rt = (float*)(c.p.ws + WS::ROPE);
        const int n = (T / 64 + 64) * 16;
        for (int i = c.bid * NTHR + tid; i < n; i += c.nblk * NTHR) {
            const int pos = i / 16, j = i % 16;
            const float invf = powf(10000.0f, -(float)j / 16.0f);
            const float idx = pos < T / 64 ? (float)pos : (float)(pos - T / 64);
            const float ang = idx * invf;
            rt[2 * i] = cosf(ang); rt[2 * i + 1] = sinf(ang);
        }
    }
}

template <class MapFn>
DEV void convert_tile(const Ctx& c, MapFn colptr, size_t ld, int K, bf16_t* __restrict__ dst, int it, int nkt) {
    LDSQ unsigned* tile = (LDSQ unsigned*)c.smem;
    const int tid = TIDX, lane = tid & 63, wave = tid >> 6;
    const int k0 = (it % nkt) * 64, n0 = (it / nkt) * 256;
    const float* src = colptr(n0 + 4 * lane);
    f32x4 v[8];
#pragma unroll
    for (int j = 0; j < 8; ++j) v[j] = src ? *(const f32x4*)(src + (size_t)(k0 + wave * 8 + j) * ld) : (f32x4){0.f, 0.f, 0.f, 0.f};
#pragma unroll
    for (int j = 0; j < 4; ++j)
#pragma unroll
        for (int i = 0; i < 4; ++i) tile[(4 * lane + i) * 33 + wave * 4 + j] = pack2(v[2 * j][i], v[2 * j + 1][i]);
    __syncthreads();
#pragma unroll
    for (int i = 0; i < 4; ++i) {
        const int id = tid + NTHR * i, n = id >> 3, ch = id & 7;
        u32x4 w; w.x = tile[n * 33 + 4 * ch]; w.y = tile[n * 33 + 4 * ch + 1]; w.z = tile[n * 33 + 4 * ch + 2]; w.w = tile[n * 33 + 4 * ch + 3];
        *(u32x4*)(dst + (size_t)(n0 + n) * K + k0 + ch * 8) = w;
    }
    __syncthreads();
}
struct ColMap {
    int mode; const float* a; const float* b;
    DEV const float* operator()(int n) const {
        if (mode == 0) return a + n;
        if (mode == 1) { if (n < 4096) return a + n; if (n < LDP) return a + n + 16; if (n < LDP + 16) return a + 4096 + (n - LDP); return nullptr; }
        const int hb = n >> 5, w = n & 31; return (w < 16 ? a : b) + 16 * hb + (w & 15);
    }
};
DEV void phase_convert(const Ctx& c, int l) {
    unsigned char* ws = c.p.ws;
    const size_t wso = (size_t)(l & 1) * WS::WSET;
    constexpr int T_IN = (D / 64) * (NPIN / 256), T_GLU = (512 / 64) * (512 / 256), T_BR = (512 / 64) * (D / 256), T_OUT = (D / 64) * (D / 256);
    constexpr int T_GU = (D / 64) * (2 * DE / 256), T_DN = (DE / 64) * (D / 256), T_EX = T_GU + T_DN;
    constexpr int O_GLU = T_IN, O_BR = O_GLU + T_GLU, O_OUT = O_BR + 3 * T_BR, O_EX = O_OUT + T_OUT, T_ALL = O_EX + NE * T_EX;
    for (int t = c.bid; t < T_ALL; t += c.nblk) {
        if (t < O_GLU) convert_tile(c, ColMap{1, c.p.in[I_WIN] + (size_t)l * D * DIN, nullptr}, DIN, D, (bf16_t*)(ws + WS::WIN + wso), t, D / 64);
        else if (t < O_BR) convert_tile(c, ColMap{0, c.p.in[I_S5GLU] + (size_t)l * 512 * 512, nullptr}, 512, 512, (bf16_t*)(ws + WS::WGLU + wso), t - O_GLU, 512 / 64);
        else if (t < O_OUT) { const int j = (t - O_BR) / T_BR, it = (t - O_BR) % T_BR; convert_tile(c, ColMap{0, c.p.in[I_WBR] + ((size_t)l * 3 + j) * 512 * D, nullptr}, D, 512, (bf16_t*)(ws + WS::WBR + wso) + (size_t)j * D * 512, it, 512 / 64); }
        else if (t < O_EX) convert_tile(c, ColMap{0, c.p.in[I_WOUT] + (size_t)l * D * D, nullptr}, D, D, (bf16_t*)(ws + WS::WOUT + wso), t - O_OUT, D / 64);
        else {
            const int u = t - O_EX, e = u / T_EX, r = u % T_EX;
            if (r < T_GU) convert_tile(c, ColMap{2, c.p.in[I_WEG] + ((size_t)l * NE + e) * D * DE, c.p.in[I_WEU] + ((size_t)l * NE + e) * D * DE}, DE, D, (bf16_t*)(ws + WS::WGU + wso) + (size_t)e * 2 * DE * D, r, D / 64);
            else convert_tile(c, ColMap{0, c.p.in[I_WED] + ((size_t)l * NE + e) * DE * D, nullptr}, D, DE, (bf16_t*)(ws + WS::WDN + wso) + (size_t)e * D * DE, r - T_GU, DE / 64);
        }
    }
}

DEV void phase_norm(const Ctx& c, int l, int which) {
    const int lane = TIDX & 63, wave = TIDX >> 6;
    const float* xc = (const float*)(c.p.ws + WS::XCUR);
    bf16_t* dst = (bf16_t*)(c.p.ws + WS::A1);
    const float* modv = (const float*)(c.p.ws + WS::MODV) + (size_t)l * 3 * 6 * D;
    constexpr int NV = D / 256;
    for (int row = c.bid * 8 + wave; row < R; row += c.nblk * 8) {
        const float* xr = xc + (size_t)row * D;
        f32x4 v[NV]; float ss = 0.f;
#pragma unroll
        for (int i = 0; i < NV; ++i) { v[i] = *(const f32x4*)(xr + i * 256 + lane * 4); ss += v[i][0] * v[i][0] + v[i][1] * v[i][1] + v[i][2] * v[i][2] + v[i][3] * v[i][3]; }
        ss = wave_sum(ss);
        const float inv = 1.0f / sqrtf(ss * (1.0f / D) + EPS);
        const float* mv = modv + (size_t)row_cond(row) * 6 * D + which * 3 * D;
#pragma unroll
        for (int i = 0; i < NV; ++i) {
            const int col = i * 256 + lane * 4;
            const f32x4 sh = *(const f32x4*)(mv + col), sc = *(const f32x4*)(mv + D + col);
            const f32x4 o = v[i] * inv * (sc + 1.0f) + sh;
            st_bf4(dst + (size_t)row * D + col, o);
        }
    }
}

DEV void phase_inproj(const Ctx& c) {
    const bf16_t* A = (const bf16_t*)(c.p.ws + WS::A1); const bf16_t* Bt = (const bf16_t*)(c.p.ws + WS::WIN + (size_t)c.par * WS::WSET);
    bf16_t* P = (bf16_t*)(c.p.ws + WS::PBUF); float* gates = (float*)(c.p.ws + WS::GATES);
    constexpr int NMT = R / 256, NNT = NPIN / 256;
    for (int rnd = 0;; ++rnd) {
        int mt, nt; if (!tile_order(rnd, c.bid, c.nblk, NMT, NNT, mt, nt)) break;
        const int m0 = mt * 256, n0 = nt * 256;
        f32x4 acc[GBig::MI][GBig::NI]; zero_acc<GBig>(acc);
        gemm_acc<GBig>(acc, [=](int m) { return A + (size_t)m * D; }, Bt, D, m0, n0, D, c.smem);
        epi_lds_bf16<GBig>(acc, m0, n0, c.smem,
            [=](int row, int col, f32x4 v) { if (col >= LDP && col < LDP + 16) *(f32x4*)(gates + (size_t)row * 16 + (col - LDP)) = v; return v; },
            [=](int row, int col, u32x4 w) { if (col < LDP) *(u32x4*)(P + (size_t)row * LDP + col) = w; });
    }
}

template <int KMODE> DEV void probe_inproj(const Ctx& c) {
    const bf16_t* A = (const bf16_t*)(c.p.ws + WS::A1); const bf16_t* Bt = (const bf16_t*)(c.p.ws + WS::WIN + (size_t)c.par * WS::WSET);
    float* gates = (float*)(c.p.ws + WS::GATES);
    constexpr int NMT = R / 256, NNT = NPIN / 256;
    for (int rnd = 0;; ++rnd) {
        int mt, nt; if (!tile_order(rnd, c.bid, c.nblk, NMT, NNT, mt, nt)) break;
        f32x4 acc[GBig::MI][GBig::NI]; zero_acc<GBig>(acc);
        gemm_acc<GBig, false, KMODE>(acc, [=](int m) { return A + (size_t)m * D; }, Bt, D, mt * 256, nt * 256, D, c.smem);
        float sgn = 0.f;
#pragma unroll
        for (int i = 0; i < GBig::MI; ++i)
#pragma unroll
            for (int j = 0; j < GBig::NI; ++j)
#pragma unroll
                for (int r = 0; r < 4; ++r) sgn += acc[i][j][r];
        if (sgn == 123456.789f) gates[0] = sgn;
    }
}
constexpr int PT_STRIDE = 1040;
DEV void tile_transpose_out(lds_t tile, bf16_t* dst, int b, int pos0, bool perm) {
    const int tid = TIDX;
#pragma unroll 1
    for (int i = 0; i < 8; ++i) {
        const int chunk = tid + NTHR * i, ch = chunk >> 3, pc = chunk & 7;
        unsigned short e[8];
#pragma unroll
        for (int j = 0; j < 8; ++j) {
            const int o = perm ? (32 * (pc >> 2) + 16 * (j >> 2) + 4 * (pc & 3) + (j & 3)) : (8 * pc + j);
            e[j] = *(LDSQ const unsigned short*)(tile + o * PT_STRIDE + ch * 2);
        }
        u32x4 w; w.x = e[0] | ((unsigned)e[1] << 16); w.y = e[2] | ((unsigned)e[3] << 16); w.z = e[4] | ((unsigned)e[5] << 16); w.w = e[6] | ((unsigned)e[7] << 16);
        *(u32x4*)(dst + ((size_t)b * 512 + ch) * TK + pos0 + pc * 8) = w;
    }
}
DEV void tile_load(lds_t tile, const bf16_t* P, int row_first, int nrows, int col0, int valid_lo, int valid_hi) {
    const int tid = TIDX;
    for (int chunk = tid; chunk < nrows * 64; chunk += NTHR) {
        const int r = chunk >> 6, cc = chunk & 63, row = row_first + r;
        u32x4 v = (u32x4){0u, 0u, 0u, 0u};
        if (row >= valid_lo && row < valid_hi) v = ldg16(P + (size_t)row * LDP + col0 + cc * 8);
        lds_st16(tile + r * PT_STRIDE + cc * 16, v);
    }
}
DEV void phase_prep(const Ctx& c, int l) {
    unsigned char* ws = c.p.ws;
    const bf16_t* P = (const bf16_t*)(ws + WS::PBUF);
    const int tid = TIDX, lane = tid & 63, wave = tid >> 6;
    const int nitem = NCH * 6;
    for (int it = c.bid; it < nitem; it += c.nblk) {
        const int sub = it % 6, tl = it / 6;
        const int b = tl / NCHB, pos0 = (tl % NCHB) * 64;
        const int row0 = bpos_row(b, pos0);
        const bool latent = pos0 >= TC;
        if (sub == 0) {
            const float* rt = (const float*)(ws + WS::ROPE);
            for (int task = wave; task < 128; task += 8) {
                const int s = task >> 1, which = task & 1, row = row0 + s, pos = pos0 + s;
                const u32x4 raw = ldg16(P + (size_t)row * LDP + which * 512 + lane * 8);
                float x[8];
#pragma unroll
                for (int e = 0; e < 4; ++e) { x[2 * e] = __uint_as_float(raw[e] << 16); x[2 * e + 1] = __uint_as_float(raw[e] & 0xffff0000u); }
                float ss = 0.f;
#pragma unroll
                for (int e = 0; e < 8; ++e) ss += x[e] * x[e];
                ss += __shfl_xor(ss, 1); ss += __shfl_xor(ss, 2); ss += __shfl_xor(ss, 4);
                const float inv = 1.0f / sqrtf(ss * (1.0f / 64.0f) + EPS);
                const float* gain = (which ? c.p.in[I_KG] : c.p.in[I_QG]) + (size_t)l * 64 + (lane & 7) * 8;
                float y[8], o[8];
#pragma unroll
                for (int e = 0; e < 8; ++e) y[e] = x[e] * inv * gain[e];
                if (latent) {
                    const int t = pos - TC, hi = (lane >> 2) & 1;
#pragma unroll
                    for (int e = 0; e < 8; ++e) {
                        const float other = __shfl_xor(y[e], 4);
                        const int jj = (lane & 3) * 8 + e;
                        const float* cs = jj < 16 ? rt + ((size_t)(t / 64) * 16 + jj) * 2 : rt + ((size_t)(T / 64 + (t % 64)) * 16 + (jj - 16)) * 2;
                        o[e] = hi ? (y[e] * cs[0] + other * cs[1]) : (y[e] * cs[0] - other * cs[1]);
                    }
                } else {
#pragma unroll
                    for (int e = 0; e < 8; ++e) o[e] = y[e];
                }
                const float scl = which ? 1.0f : 0.18033688011112042f;
                u32x4 w; w.x = pack2(o[0] * scl, o[1] * scl); w.y = pack2(o[2] * scl, o[3] * scl); w.z = pack2(o[4] * scl, o[5] * scl); w.w = pack2(o[6] * scl, o[7] * scl);
                const int grp = lane >> 3, head = grp >> 1, map = grp & 1;
                bf16_t* dst = (bf16_t*)(ws + (which ? WS::KP : WS::QP)) + (((size_t)b * 4 + head) * TK + pos) * 128 + map * 64 + (lane & 7) * 8;
                *(u32x4*)dst = w;
            }
        } else if (sub == 1) {
            tile_load(c.smem, P, row0, 64, 1024, 0, R); __syncthreads();
            tile_transpose_out(c.smem, (bf16_t*)(ws + WS::VT), b, pos0, true); __syncthreads();
        } else if (sub == 2) {
            tile_load(c.smem, P, row0, 64, 1536, 0, R); __syncthreads();
            bf16_t* ug = (bf16_t*)(ws + WS::UG);
#pragma unroll 1
            for (int i = 0; i < 8; ++i) {
                const int chunk = tid + NTHR * i, g = chunk >> 7, s = (chunk >> 1) & 63, half = chunk & 1;
                const u32x4 v = lds_ld16(c.smem + s * PT_STRIDE + g * 32 + half * 16);
                *(u32x4*)(ug + ((size_t)g * NCH + s5_cr(b, tl % NCHB)) * 1280 + s * 16 + half * 8) = v;
            }
            __syncthreads();
        } else if (sub == 3 || sub == 4) {
            const int isk = sub == 4;
            const int seg_lo = latent ? bpos_row(b, TC) : bpos_row(b, 0), seg_hi = seg_lo + (latent ? T : TC);
            tile_load(c.smem, P, row0 - 2, 68, isk ? 2560 : 2048, seg_lo, seg_hi); __syncthreads();
            lds_t otile = c.smem + 68 * PT_STRIDE;
            const float* cw = c.p.in[I_CONVW] + (size_t)l * 5 * 1024 + isk * 512; const float* cb = c.p.in[I_CONVB] + (size_t)l * 1024 + isk * 512;
            bf16_t* dst = (bf16_t*)(ws + (isk ? WS::MK : WS::MQ));
#pragma unroll 1
            for (int i = 0; i < 8; ++i) {
                const int chunk = tid + NTHR * i, s = chunk >> 6, cc = chunk & 63;
                float a[8];
#pragma unroll
                for (int e = 0; e < 8; ++e) a[e] = cb[cc * 8 + e];
#pragma unroll
                for (int j = 0; j < 5; ++j) {
                    const u32x4 raw = lds_ld16(c.smem + (s + j) * PT_STRIDE + cc * 16);
#pragma unroll
                    for (int e = 0; e < 4; ++e) { a[2 * e] += __uint_as_float(raw[e] << 16) * cw[j * 1024 + cc * 8 + 2 * e]; a[2 * e + 1] += __uint_as_float(raw[e] & 0xffff0000u) * cw[j * 1024 + cc * 8 + 2 * e + 1]; }
                }
                const float scl = isk ? 0.08838834764831845f : 1.0f;
#pragma unroll
                for (int e = 0; e < 8; ++e) a[e] = siluf_(a[e]) * scl;
                u32x4 w; w.x = pack2(a[0], a[1]); w.y = pack2(a[2], a[3]); w.z = pack2(a[4], a[5]); w.w = pack2(a[6], a[7]);
                const int ch = cc * 8, head = ch >> 7, d = ch & 127;
                *(u32x4*)(dst + (((size_t)b * 4 + head) * TK + pos0 + s) * 128 + d) = w;
                if (isk) lds_st16(otile + s * PT_STRIDE + cc * 16, w);
            }
            __syncthreads();
            if (isk) { tile_transpose_out(otile, (bf16_t*)(ws + WS::MKT), b, pos0, false); __syncthreads(); }
        } else {
            tile_load(c.smem, P, row0, 64, 3072, 0, R); __syncthreads();
            tile_transpose_out(c.smem, (bf16_t*)(ws + WS::MVT), b, pos0, false);
            const float* gates = (const float*)(ws + WS::GATES);
            float* ig = (float*)(ws + WS::MIG); float* lf = (float*)(ws + WS::MLF);
            {
                const int s = tid >> 3, dir = (tid >> 2) & 1, head = tid & 3, row = row0 + s;
                const float gi = gates[(size_t)row * 16 + dir * 8 + head] + c.p.in[I_IB][(size_t)l * 8 + dir * 4 + head];
                const float gf = gates[(size_t)row * 16 + dir * 8 + 4 + head] + c.p.in[I_FB][(size_t)l * 8 + dir * 4 + head];
                const size_t o = (((size_t)dir * NB + b) * 4 + head) * TK + pos0 + s;
                ig[o] = gi;
                lf[o] = fminf(gf, 0.f) - log1pf(fexp(-fabsf(gf)));
            }
            __syncthreads();
        }
    }
}

constexpr int ATT_KB = 128 * 256, ATT_STAGE = ATT_KB + 128 * 256;
DEV void attn_item(const Ctx& c, int l, int b, int head, int qpos0, int nkeys) {
    unsigned char* ws = c.p.ws;
    const int tid = TIDX, lane = tid & 63, wave = tid >> 6, fr = lane & 31, fh = lane >> 5, map = wave >> 2, qg = wave & 3;
    const bf16_t* Q = (const bf16_t*)(ws + WS::QP) + ((size_t)b * 4 + head) * TK * 128;
    const bf16_t* Kp = (const bf16_t*)(ws + WS::KP) + ((size_t)b * 4 + head) * TK * 128;
    const bf16_t* Vt = (const bf16_t*)(ws + WS::VT) + ((size_t)b * 4 + head) * 128 * TK;
    float gqm = 0.f, gkm = 0.f, d01 = 0.f, d23 = 0.f;
    for (int i = 0; i < 64; ++i) {
        gqm = fmaxf(gqm, fabsf(c.p.in[I_QG][l * 64 + i])); gkm = fmaxf(gkm, fabsf(c.p.in[I_KG][l * 64 + i]));
        const float* lv = c.p.in[I_LAMV] + (size_t)l * 256;
        d01 += lv[i] * lv[64 + i]; d23 += lv[128 + i] * lv[192 + i];
    }
    const float lam_init = 0.8f - 0.6f * expf(-0.3f * (float)l);
    const float lam = expf(d01) - expf(d23) + lam_init;
    const float shift = fmaxf(0.0f, 8.0f * gqm * gkm * 1.44269504089f * 1.02f - 64.0f);
    const int r16 = lane & 15, kq = lane >> 4;
    bf16x8 qf[2][2];
#pragma unroll
    for (int qt = 0; qt < 2; ++qt) {
        const bf16_t* qr = Q + (size_t)(qpos0 + qg * 32 + qt * 16 + r16) * 128 + map * 64 + kq * 8;
        qf[qt][0] = as_bf8(ldg16(qr)); qf[qt][1] = as_bf8(ldg16(qr + 32));
    }
    f32x4 O[8][2];
#pragma unroll
    for (int t = 0; t < 8; ++t) { O[t][0] = (f32x4){0.f, 0.f, 0.f, 0.f}; O[t][1] = O[t][0]; }
    const int wv = uniform_i(wave);
    const int pr0 = tid >> 4;
    const int plc = ((lane & 15) ^ (pr0 & 15)) << 3;
    gbf_t pk0 = (gbf_t)(Kp + (size_t)pr0 * 128 + plc);
    gbf_t pv0 = (gbf_t)(Vt + (size_t)pr0 * TK + plc);
#ifndef EMU
    asm volatile("" : "+v"(pv0));
#define ATT_SB() __builtin_amdgcn_sched_barrier(0)
#else
#define ATT_SB()
#endif
    auto issue = [&](int st) {
        lds_t base = c.smem + st * ATT_STAGE + wv * 1024;
#pragma unroll
        for (int i = 0; i < 4; ++i) { glds16((const void*)(pk0 + (size_t)i * 32 * 128), base + i * 8192); glds16((const void*)(pv0 + (size_t)i * 32 * TK), base + ATT_KB + i * 8192); }
    };
    auto advance = [&]() { pk0 += 128 * 128; pv0 += 128; };
    const int xk = r16;
    int koff[2], voff[4];
#pragma unroll
    for (int kh = 0; kh < 2; ++kh) koff[kh] = r16 * 256 + ((((map ^ (xk >> 3)) << 3) + ((kh ^ ((xk >> 2) & 1)) << 2) + (kq ^ (xk & 3))) << 4);
#pragma unroll
    for (int sub = 0; sub < 4; ++sub) voff[sub] = ATT_KB + r16 * 256 + ((((sub ^ (xk >> 2)) << 2) + (kq ^ (xk & 3))) << 4);
    const int nkt = nkeys / 128;
    issue(0); __syncthreads(); advance();
    f32x4 ls[2] = {(f32x4){0.f, 0.f, 0.f, 0.f}, (f32x4){0.f, 0.f, 0.f, 0.f}};
#pragma unroll 1
    for (int kt = 0; kt < nkt; ++kt) {
        if (kt + 1 < nkt) issue((kt + 1) & 1);
        lds_t sb = c.smem + (kt & 1) * ATT_STAGE;
#pragma unroll
        for (int hp = 0; hp < 2; ++hp) {
            bf16x8 kf[2][2], vf[8], pf[2];
            f32x4 S0[2][2], S1[2][2];
#pragma unroll
            for (int k2 = 0; k2 < 2; ++k2)
#pragma unroll
                for (int kh = 0; kh < 2; ++kh) kf[k2][kh] = as_bf8(lds_ld16(sb + koff[kh] + hp * 16384 + k2 * 4096));
#pragma unroll
            for (int k2 = 0; k2 < 2; ++k2)
#pragma unroll
                for (int qt = 0; qt < 2; ++qt) { S0[k2][qt] = (f32x4){0.f, 0.f, 0.f, 0.f}; S1[k2][qt] = S0[k2][qt]; }
#pragma unroll
            for (int kh = 0; kh < 2; ++kh)
#pragma unroll
                for (int k2 = 0; k2 < 2; ++k2)
#pragma unroll
                    for (int qt = 0; qt < 2; ++qt) S0[k2][qt] = mfma16(kf[k2][kh], qf[qt][kh], S0[k2][qt]);
#pragma unroll
            for (int dvt = 0; dvt < 8; ++dvt) vf[dvt] = as_bf8(lds_ld16(sb + voff[2 * hp] + dvt * 4096));
#pragma unroll
            for (int k2 = 0; k2 < 2; ++k2)
#pragma unroll
                for (int kh = 0; kh < 2; ++kh) kf[k2][kh] = as_bf8(lds_ld16(sb + koff[kh] + hp * 16384 + 8192 + k2 * 4096));
            ATT_SB();
#pragma unroll
            for (int kh = 0; kh < 2; ++kh)
#pragma unroll
                for (int k2 = 0; k2 < 2; ++k2)
#pragma unroll
                    for (int qt = 0; qt < 2; ++qt) S1[k2][qt] = mfma16(kf[k2][kh], qf[qt][kh], S1[k2][qt]);
            if (shift != 0.f) {
#pragma unroll
                for (int k2 = 0; k2 < 2; ++k2)
#pragma unroll
                    for (int qt = 0; qt < 2; ++qt) { S0[k2][qt] -= shift; S1[k2][qt] -= shift; }
            }
#pragma unroll
            for (int qt = 0; qt < 2; ++qt) {
#pragma unroll
                for (int k2 = 0; k2 < 2; ++k2)
#pragma unroll
                    for (int r = 0; r < 4; ++r) S0[k2][qt][r] = fexp2(S0[k2][qt][r]);
                ls[qt] += S0[0][qt] + S0[1][qt];
                pf[qt] = as_bf8(pack8f(S0[0][qt], S0[1][qt]));
            }
            ATT_SB();
#pragma unroll
            for (int dvt = 0; dvt < 8; ++dvt) { O[dvt][0] = mfma16(vf[dvt], pf[0], O[dvt][0]); O[dvt][1] = mfma16(vf[dvt], pf[1], O[dvt][1]); }
#pragma unroll
            for (int dvt = 0; dvt < 8; ++dvt) vf[dvt] = as_bf8(lds_ld16(sb + voff[2 * hp + 1] + dvt * 4096));
#pragma unroll
            for (int qt = 0; qt < 2; ++qt) {
#pragma unroll
                for (int k2 = 0; k2 < 2; ++k2)
#pragma unroll
                    for (int r = 0; r < 4; ++r) S1[k2][qt][r] = fexp2(S1[k2][qt][r]);
                ls[qt] += S1[0][qt] + S1[1][qt];
                pf[qt] = as_bf8(pack8f(S1[0][qt], S1[1][qt]));
            }
            ATT_SB();
#pragma unroll
            for (int dvt = 0; dvt < 8; ++dvt) { O[dvt][0] = mfma16(vf[dvt], pf[0], O[dvt][0]); O[dvt][1] = mfma16(vf[dvt], pf[1], O[dvt][1]); }
        }
        __syncthreads();
        advance();
    }
    float lt[2];
#pragma unroll
    for (int qt = 0; qt < 2; ++qt) { float v = (ls[qt][0] + ls[qt][1]) + (ls[qt][2] + ls[qt][3]); v += __shfl_xor(v, 16); v += __shfl_xor(v, 32); lt[qt] = v; }
    LDSQ float* xch = (LDSQ float*)c.smem;
    if (map == 1) {
#pragma unroll
        for (int qt = 0; qt < 2; ++qt) {
            const float sc = lam / lt[qt];
#pragma unroll
            for (int t = 0; t < 8; ++t)
#pragma unroll
                for (int r = 0; r < 4; ++r) xch[(qg * 64 + (t * 2 + qt) * 4 + r) * 64 + lane] = O[t][qt][r] * sc;
        }
    }
    __syncthreads();
    if (map == 0) {
        const float* og = c.p.in[I_OG] + (size_t)l * 128;
#pragma unroll
        for (int qt = 0; qt < 2; ++qt) {
            const float i0 = 1.0f / lt[qt];
            float ss = 0.f;
#pragma unroll
            for (int t = 0; t < 8; ++t)
#pragma unroll
                for (int r = 0; r < 4; ++r) { const float o = O[t][qt][r] * i0 - xch[(qg * 64 + (t * 2 + qt) * 4 + r) * 64 + lane]; O[t][qt][r] = o; ss += o * o; }
            ss += __shfl_xor(ss, 16); ss += __shfl_xor(ss, 32);
            const float inv = (1.0f - lam_init) / sqrtf(ss * (1.0f / 128.0f) + EPS);
            const int row = bpos_row(b, qpos0 + qg * 32 + qt * 16 + r16);
            bf16_t* ya = (bf16_t*)(ws + WS::YA) + (size_t)row * 512 + head * 128;
#pragma unroll
            for (int t = 0; t < 8; ++t) {
                const int dv = 16 * t + 4 * kq;
                st_bf4(ya + dv, O[t][qt] * inv * *(const f32x4*)(og + dv));
            }
        }
    }
    __syncthreads();
}
constexpr int ATT_QB = T / 128, ATT_LAT = NB * 4 * ATT_QB, ATT_CTX = NB * 4 * (TC / 128);
DEV void s5_local_item(const Ctx& c, int it);
DEV void ml_local_item(const Ctx& c, int it);
DEV void phase_mix1(const Ctx& c, int l) {
    for (int rep = 0; rep < (PROBE_SUB == 1 ? 2 : 1); ++rep)
    for (int it = c.bid; it < NB * 4 * NCM; it += c.nblk) ml_local_item(c, it);
    for (int rep = 0; rep < (PROBE_SUB == 2 ? 2 : 1); ++rep)
    for (int it = c.bid; it < 32 * ((NCH + 63) / 64); it += c.nblk) s5_local_item(c, it);
    for (int rep = 0; rep < (PROBE_SUB == 3 ? 2 : 1); ++rep)
    for (int rnd = 0;; ++rnd) {
        const int it = perm_slot(rnd, c.bid, c.nblk);
        if (it >= ATT_LAT + ATT_CTX) break;
        int bh, qpos0, nkeys;
        if (it < ATT_LAT) { bh = it / ATT_QB; qpos0 = TC + (it % ATT_QB) * 128; nkeys = TK; }
        else { const int j = it - ATT_LAT; bh = j / (TC / 128); qpos0 = (j % (TC / 128)) * 128; nkeys = TC; }
        attn_item(c, l, bh >> 2, bh & 3, qpos0, nkeys);
    }
}

struct S5Base { float mag_l, ang, fre, fim; };
DEV S5Base s5_base(const Ctx& c, int l, int dir, int g, int p) {
    const size_t i = (((size_t)l * 2 + dir) * 32 + g) * 64 + p;
    const float lre = c.p.in[I_S5LRE][i], lim = c.p.in[I_S5LIM][i], dt = expf(c.p.in[I_S5STEP][((size_t)l * 2 + dir) * 32 + g]);
    S5Base r; r.mag_l = lre * dt; r.ang = lim * dt;
    const float cs = cosf(r.ang), sn = sinf(r.ang), em1 = expm1f(r.mag_l);
    const float nr = em1 * cs + (cs - 1.0f), ni = (em1 + 1.0f) * sn, den = lre * lre + lim * lim;
    r.fre = (nr * lre + ni * lim) / den; r.fim = (ni * lre - nr * lim) / den;
    return r;
}
DEV void s5_pow(const S5Base& a, int n, float& re, float& im) { const float m = expf(a.mag_l * (float)n), an = a.ang * (float)n; re = m * cosf(an); im = m * sinf(an); }
DEV void phase_s5_tab1(const Ctx& c, int l) {
    const int tid = TIDX;
    LDSQ float* sm = (LDSQ float*)c.smem;
    LDSQ float* bbar = sm;
    LDSQ float* apow = sm + 2048;
    float* kt = (float*)(c.p.ws + WS::S5KT); float* a64 = (float*)(c.p.ws + WS::S5A64) + (size_t)(l & 1) * 2 * 32 * 64 * 2;
    for (int it = c.bid; it < 32 * 2 * 8; it += c.nblk) {
        const int lb = it & 7, dir = (it >> 3) & 1, g = it >> 4;
        {
            const int p = tid & 63, ll = tid >> 6;
            const S5Base a = s5_base(c, l, dir, g, p);
            float re, im; s5_pow(a, lb * 8 + ll, re, im); apow[(ll * 64 + p) * 2] = re; apow[(ll * 64 + p) * 2 + 1] = im;
            if (lb == 0 && ll == 0) { s5_pow(a, 64, re, im); a64[((dir * 32 + g) * 64 + p) * 2] = re; a64[((dir * 32 + g) * 64 + p) * 2 + 1] = im; }
            for (int h = ll; h < 16; h += 8) {
                const size_t bi = ((((size_t)l * 2 + dir) * 32 + g) * 64 + p) * 16 + h;
                const float br = c.p.in[I_S5BRE][bi], bim = c.p.in[I_S5BIM][bi];
                bbar[(p * 16 + h) * 2] = a.fre * br - a.fim * bim; bbar[(p * 16 + h) * 2 + 1] = a.fre * bim + a.fim * br;
            }
        }
        __syncthreads();
        {
            const int ll = tid >> 6, hp = (tid >> 2) & 15, hq = tid & 3;
            const size_t ci = ((((size_t)l * 2 + dir) * 32 + g) * 16 + hp) * 64;
            float acc[4] = {0.f, 0.f, 0.f, 0.f};
            for (int p = 0; p < 64; ++p) {
                const float cr = c.p.in[I_S5CRE][ci + p], cim = c.p.in[I_S5CIM][ci + p];
                const float ar = apow[(ll * 64 + p) * 2], ai = apow[(ll * 64 + p) * 2 + 1];
                const float gr = cr * ar - cim * ai, gi = cr * ai + cim * ar;
#pragma unroll
                for (int e = 0; e < 4; ++e) acc[e] += gr * bbar[(p * 16 + hq * 4 + e) * 2] - gi * bbar[(p * 16 + hq * 4 + e) * 2 + 1];
            }
            *(f32x4*)(kt + ((((size_t)g * 2 + dir) * 64 + lb * 8 + ll) * 256 + hp * 16 + hq * 4)) = (f32x4){acc[0], acc[1], acc[2], acc[3]};
        }
        __syncthreads();
    }
}
DEV void phase_s5_tab2(const Ctx& c, int l) {
    const int tid = TIDX;
    const float* kt = (const float*)(c.p.ws + WS::S5KT);
    bf16_t* toep = (bf16_t*)(c.p.ws + WS::S5TOEP); bf16_t* minm = (bf16_t*)(c.p.ws + WS::S5MIN);
    for (int it = c.bid; it < 32 * 64; it += c.nblk) {
        const int g = it >> 6, t = it & 63;
#pragma unroll 1
        for (int i = 0; i < 4; ++i) {
            const int chunk = tid + NTHR * i, hp = chunk >> 7, kc = chunk & 127, s = kc >> 1, h0 = (kc & 1) * 8;
            const float* kf = kt + ((((size_t)g * 2 + 0) * 64 + (s < t ? t - s : 0)) * 256 + hp * 16 + h0);
            const float* kb = kt + ((((size_t)g * 2 + 1) * 64 + (s > t ? s - t : 0)) * 256 + hp * 16 + h0);
            f32x4 a0, a1;
            if (s < t) { a0 = *(const f32x4*)kf; a1 = *(const f32x4*)(kf + 4); }
            else if (s > t) { a0 = *(const f32x4*)kb; a1 = *(const f32x4*)(kb + 4); }
            else { a0 = *(const f32x4*)kf + *(const f32x4*)kb; a1 = *(const f32x4*)(kf + 4) + *(const f32x4*)(kb + 4); }
            u32x4 w; w.x = pack2(a0[0], a0[1]); w.y = pack2(a0[2], a0[3]); w.z = pack2(a1[0], a1[1]); w.w = pack2(a1[2], a1[3]);
            *(u32x4*)(toep + ((size_t)g * 1024 + t * 16 + hp) * 1280 + s * 16 + h0) = w;
        }
        if (tid < 128) {
            const int dir = tid >> 6, p = tid & 63;
            const S5Base a = s5_base(c, l, dir, g, p);
            float ar, ai; s5_pow(a, dir ? 64 - t : t + 1, ar, ai);
            for (int hp = 0; hp < 16; ++hp) {
                const size_t ci = ((((size_t)l * 2 + dir) * 32 + g) * 16 + hp) * 64 + p;
                const float cr = c.p.in[I_S5CRE][ci], cim = c.p.in[I_S5CIM][ci];
                const float gr = cr * ar - cim * ai, gi = cr * ai + cim * ar;
                *(unsigned*)(toep + ((size_t)g * 1024 + t * 16 + hp) * 1280 + 1024 + dir * 128 + p * 2) = pack2(gr, -gi);
            }
        }
    }
    for (int it = c.bid; it < 32 * 2 * 8; it += c.nblk) {
        const int pb = it & 7, dir = (it >> 3) & 1, g = it >> 4, p = pb * 8 + (tid >> 6), sidx = tid & 63;
        const S5Base a = s5_base(c, l, dir, g, p);
        float ar, ai; s5_pow(a, dir ? sidx : 63 - sidx, ar, ai);
        float vr[16], vi[16];
#pragma unroll
        for (int h = 0; h < 16; ++h) {
            const size_t bi = ((((size_t)l * 2 + dir) * 32 + g) * 64 + p) * 16 + h;
            const float br = c.p.in[I_S5BRE][bi], bim = c.p.in[I_S5BIM][bi];
            const float bbr = a.fre * br - a.fim * bim, bbi = a.fre * bim + a.fim * br;
            vr[h] = ar * bbr - ai * bbi; vi[h] = ar * bbi + ai * bbr;
        }
        bf16_t* r0 = minm + ((size_t)g * 256 + dir * 128 + p * 2) * 1024 + sidx * 16;
        u32x4 w;
        w.x = pack2(vr[0], vr[1]); w.y = pack2(vr[2], vr[3]); w.z = pack2(vr[4], vr[5]); w.w = pack2(vr[6], vr[7]); *(u32x4*)r0 = w;
        w.x = pack2(vr[8], vr[9]); w.y = pack2(vr[10], vr[11]); w.z = pack2(vr[12], vr[13]); w.w = pack2(vr[14], vr[15]); *(u32x4*)(r0 + 8) = w;
        w.x = pack2(vi[0], vi[1]); w.y = pack2(vi[2], vi[3]); w.z = pack2(vi[4], vi[5]); w.w = pack2(vi[6], vi[7]); *(u32x4*)(r0 + 1024) = w;
        w.x = pack2(vi[8], vi[9]); w.y = pack2(vi[10], vi[11]); w.z = pack2(vi[12], vi[13]); w.w = pack2(vi[14], vi[15]); *(u32x4*)(r0 + 1024 + 8) = w;
    }
}
constexpr int S5_MT = (NCH + 63) / 64;
DEV void s5_local_item(const Ctx& c, int it) {
    const int g = it / S5_MT, m0 = (it % S5_MT) * 64;
    const bf16_t* ug = (const bf16_t*)(c.p.ws + WS::UG) + (size_t)g * NCH * 1280;
    const bf16_t* Bt = (const bf16_t*)(c.p.ws + WS::S5MIN) + (size_t)g * 256 * 1024;
    float* sloc = (float*)(c.p.ws + WS::SLOC) + (size_t)g * NCH * 256;
    f32x4 acc[GSmall::MI][GSmall::NI]; zero_acc<GSmall>(acc);
    gemm_acc<GSmall, true>(acc, [=](int m) -> const bf16_t* { return ug + (size_t)(m < NCH ? m : 0) * 1280; }, Bt, 1024, m0, 0, 1024, c.smem);
    epi_lds_f32<GSmall>(acc, m0, 0, c.smem, [=](int row, int col, f32x4 a, f32x4 b) { if (row < NCH) { *(f32x4*)(sloc + (size_t)row * 256 + col) = a; *(f32x4*)(sloc + (size_t)row * 256 + col + 4) = b; } });
}
DEV void s5_scan(const Ctx& c) {
    const float* a64 = (const float*)(c.p.ws + WS::S5A64) + (size_t)c.par * 2 * 32 * 64 * 2;
    constexpr int NCC = TC / S5L;
    static_assert(NCHB % 4 == 0, "scan unroll");
    for (int idx = c.bid * NTHR + TIDX; idx < NB * 32 * 2 * 64; idx += c.nblk * NTHR) {
        const int p = idx & 63, dir = (idx >> 6) & 1, g = (idx >> 7) & 31, b = idx >> 12;
        const float ar = a64[((dir * 32 + g) * 64 + p) * 2], ai = a64[((dir * 32 + g) * 64 + p) * 2 + 1];
        const float* __restrict__ sl = (const float*)(c.p.ws + WS::SLOC) + (size_t)g * NCH * 256 + dir * 128 + p * 2;
        bf16_t* __restrict__ so = (bf16_t*)(c.p.ws + WS::UG) + (size_t)g * NCH * 1280 + 1024 + dir * 128 + p * 2;
        auto order = [&](int j) { return s5_cr(b, dir == 0 ? j : (j < NCC ? NCC - 1 - j : NCHB - 1 - (j - NCC))); };
        float sr = 0.f, si = 0.f;
        constexpr int NG = NCHB / 4;
        float2 cur[4], n1[4], n2[4], nn[4];
#pragma unroll
        for (int u = 0; u < 4; ++u) { cur[u] = *(const float2*)(sl + (size_t)order(u) * 256); n1[u] = NG > 1 ? *(const float2*)(sl + (size_t)order(4 + u) * 256) : cur[u]; n2[u] = NG > 2 ? *(const float2*)(sl + (size_t)order(8 + u) * 256) : cur[u]; }
#pragma unroll 1
        for (int g2 = 0; g2 < NG; ++g2) {
            if (g2 + 3 < NG) {
#pragma unroll
                for (int u = 0; u < 4; ++u) nn[u] = *(const float2*)(sl + (size_t)order(4 * (g2 + 3) + u) * 256);
            }
#pragma unroll
            for (int u = 0; u < 4; ++u) {
                *(unsigned*)(so + (size_t)order(4 * g2 + u) * 1280) = pack2(sr, si);
                const float nr = ar * sr - ai * si + cur[u].x, ni = ar * si + ai * sr + cur[u].y;
                sr = nr; si = ni;
            }
#pragma unroll
            for (int u = 0; u < 4; ++u) { cur[u] = n1[u]; n1[u] = n2[u]; n2[u] = nn[u]; }
        }
    }
}
DEV float gelu_tanh(float x) { const float z = 0.7978845608028654f * (x + 0.044715f * x * x * x); const float t = 1.0f - 2.0f * frcp(1.0f + fexp(2.0f * z)); return 0.5f * x * (1.0f + t); }
template <class G> DEV void s5_out_tile(const Ctx& c, int l, int g, int m0, int n0) {
    const bf16_t* ug = (const bf16_t*)(c.p.ws + WS::UG) + (size_t)g * NCH * 1280;
    const bf16_t* Bt = (const bf16_t*)(c.p.ws + WS::S5TOEP) + (size_t)g * 1024 * 1280;
    bf16_t* yg = (bf16_t*)(c.p.ws + WS::YG);
    const float* dvec = c.p.in[I_S5D] + (size_t)l * 512 + g * 16;
    f32x4 acc[G::MI][G::NI]; zero_acc<G>(acc);
    gemm_acc<G, true>(acc, [=](int m) -> const bf16_t* { return ug + (size_t)(m < NCH ? m : 0) * 1280; }, Bt, 1280, m0, n0, 1280, c.smem);
    auto fin = [=](int row, int col, f32x4 a, f32x4 bq) -> u32x4 {
        f32x4 ua, ub; unpack8f(ldg16(ug + (size_t)row * 1280 + col), ua, ub);
        const int hp = col & 15;
        const f32x4 da = *(const f32x4*)(dvec + hp), db = *(const f32x4*)(dvec + hp + 4);
        f32x4 ya, yb2;
#pragma unroll
        for (int e = 0; e < 4; ++e) { ya[e] = gelu_tanh(a[e] + da[e] * ua[e]); yb2[e] = gelu_tanh(bq[e] + db[e] * ub[e]); }
        return pack8f(ya, yb2);
    };
    auto dstp = [=](int row, int col) -> bf16_t* { int b, pos0; s5_cr_inv(row, b, pos0); return yg + (size_t)bpos_row(b, pos0 + (col >> 4)) * 512 + g * 16 + (col & 15); };
    if constexpr (G::BM * (G::BN * 4 + 16) <= 160 * 1024 - 64) {
        epi_lds_f32<G>(acc, m0, n0, c.smem, [=](int row, int col, f32x4 a, f32x4 bq) { if (row < NCH) *(u32x4*)dstp(row, col) = fin(row, col, a, bq); });
    } else {
        epi_lds_bf16<G>(acc, m0, n0, c.smem,
            [=](int row, int col, f32x4 v) {
                const u32x2 ur = *(const u32x2*)(ug + (size_t)(row < NCH ? row : 0) * 1280 + col); const f32x4 d4 = *(const f32x4*)(dvec + (col & 15));
                f32x4 y;
                y[0] = gelu_tanh(v[0] + d4[0] * __uint_as_float(ur.x << 16)); y[1] = gelu_tanh(v[1] + d4[1] * __uint_as_float(ur.x & 0xffff0000u));
                y[2] = gelu_tanh(v[2] + d4[2] * __uint_as_float(ur.y << 16)); y[3] = gelu_tanh(v[3] + d4[3] * __uint_as_float(ur.y & 0xffff0000u));
                return y; },
            [=](int row, int col, u32x4 w) { if (row < NCH) *(u32x4*)dstp(row, col) = w; });
    }
}
constexpr bool S5_BIG = (NRL5 % 256 == 0);
constexpr int S5_BIG_IT = S5_BIG ? 32 * (NRL5 / 256) * 4 : 0, S5_SM_R0 = S5_BIG ? NRL5 : 0, S5_SM_MT = (NCH - S5_SM_R0 + 63) / 64, S5_SM_IT = 32 * S5_SM_MT * 4;
DEV void s5_out_item(const Ctx& c, int l, int it) {
    if (it < S5_BIG_IT) { const int nt = it & 3, mt = (it >> 2) % (NRL5 / 256), g = (it >> 2) / (NRL5 / 256); s5_out_tile<GBig>(c, l, g, mt * 256, nt * 256); }
    else { const int j = it - S5_BIG_IT, nt = j & 3, mt = (j >> 2) % S5_SM_MT, g = (j >> 2) / S5_SM_MT; s5_out_tile<GSmall>(c, l, g, S5_SM_R0 + mt * 64, nt * 256); }
}
template <class G> DEV void glu_tile(const Ctx& c, int m0, int n0) {
    const bf16_t* A = (const bf16_t*)(c.p.ws + WS::YG); const bf16_t* Bt = (const bf16_t*)(c.p.ws + WS::WGLU + (size_t)c.par * WS::WSET); bf16_t* yb = (bf16_t*)(c.p.ws + WS::YB);
    f32x4 acc[G::MI][G::NI]; zero_acc<G>(acc);
    gemm_acc<G>(acc, [=](int m) { return A + (size_t)m * 512; }, Bt, 512, m0, n0, 512, c.smem);
    epi_lds_f32<G>(acc, m0, n0, c.smem, [=](int row, int col, f32x4 a, f32x4 bq) {
        f32x4 ga, gb; unpack8f(ldg16(A + (size_t)row * 512 + col), ga, gb);
#pragma unroll
        for (int e = 0; e < 4; ++e) { ga[e] *= sigmoidf_(a[e]); gb[e] *= sigmoidf_(bq[e]); }
        *(u32x4*)(yb + (size_t)row * 512 + col) = pack8f(ga, gb);
    });
}
DEV void ml_out_item(const Ctx& c, int it);
constexpr int GLU_LT = (RL / 256) * 4, GLU_CT = (RC / 64) * 2, ML_CTX_IT = NB * 4 * NCMC;
DEV void phase_glu(const Ctx& c) {
    for (int j = c.nblk - 1 - c.bid; j < ML_CTX_IT; j += c.nblk) ml_out_item(c, (j / NCMC) * NCM + (j % NCMC));
    for (int rnd = 0;; ++rnd) {
        const int it = perm_slot(rnd, c.bid, c.nblk);
        if (it >= GLU_LT + GLU_CT) break;
        if (it < GLU_LT) { int mt, nt; grouped_tile(it, RL / 256, 4, mt, nt); glu_tile<GMid>(c, mt * 256, nt * 128); }
        else { const int j = it - GLU_LT; glu_tile<GSmall>(c, RL + (j % (RC / 64)) * 64, (j / (RC / 64)) * 256); }
    }
}

DEV int ml_order(int dir, int j) { return dir == 0 ? j : (j < NCMC ? NCMC - 1 - j : NCM - 1 - (j - NCMC)); }
DEV void unpack8(u32x4 raw, float (&x)[8]) {
#pragma unroll
    for (int e = 0; e < 4; ++e) { x[2 * e] = __uint_as_float(raw[e] << 16); x[2 * e + 1] = __uint_as_float(raw[e] & 0xffff0000u); }
}
DEV float wave_incl_scan_f(float v) {
    const int lane = TIDX & 63;
#pragma unroll
    for (int d = 1; d < 64; d <<= 1) { const float y = __shfl_up(v, d); if (lane >= d) v += y; }
    return v;
}
DEV void ml_local_item(const Ctx& c, int it) {
    unsigned char* ws = c.p.ws;
    const int tid = TIDX, lane = tid & 63, wave = tid >> 6, fr = lane & 31, fh = lane >> 5;
    const int cc = it % NCM, bh = it / NCM, pos0 = cc * MLC;
    LDSQ float* sm = (LDSQ float*)c.smem;
    LDSQ float* s_ew = sm;
    LDSQ float* s_x = sm + 256;
    LDSQ float* s_part = sm + 512;
    float wv = 0.f;
    {
        const int dir = (tid >> 7) & 1, t = tid & 127;
        float lfv = 0.f, igv = 0.f;
        if (tid < 256) { const size_t o = ((size_t)dir * NB * 4 + bh) * TK + pos0 + t; lfv = ((const float*)(ws + WS::MLF))[o]; igv = ((const float*)(ws + WS::MIG))[o]; }
        float inc = wave_incl_scan_f(lfv);
        if (tid < 256 && lane == 63) s_x[wave] = inc;
        __syncthreads();
        if (tid < 256) {
            const float lo = s_x[2 * dir], hi = s_x[2 * dir + 1], tot = lo + hi;
            if (wave & 1) inc += lo;
            const float cum = dir == 0 ? inc : tot - (inc - lfv);
            wv = tot - cum + igv;
            if (t == 0) s_x[8 + dir] = tot;
        }
        float m = wave_max(tid < 256 ? wv : -3.0e38f);
        if (tid < 256 && lane == 0) s_x[4 + wave] = m;
        __syncthreads();
        if (tid < 256) { const float mw = fmaxf(s_x[4 + 2 * dir], s_x[5 + 2 * dir]); s_ew[dir * 128 + t] = fexp(wv - mw); if (t == 0) s_x[10 + dir] = mw; }
        __syncthreads();
    }
    {
        const int vt = wave >> 1, kh = wave & 1;
        const bf16_t* vT = (const bf16_t*)(ws + WS::MVT) + ((size_t)bh * 128 + vt * 32 + fr) * TK + pos0 + fh * 8;
        const bf16_t* kT = (const bf16_t*)(ws + WS::MKT) + ((size_t)bh * 128 + kh * 64 + fr) * TK + pos0 + fh * 8;
        f32x16 acc[2][2];
#pragma unroll
        for (int r = 0; r < 16; ++r) { acc[0][0][r] = 0.f; acc[0][1][r] = 0.f; acc[1][0][r] = 0.f; acc[1][1][r] = 0.f; }
#pragma unroll 2
        for (int ks = 0; ks < 8; ++ks) {
            float x[8]; unpack8(ldg16(vT + ks * 16), x);
            const bf16x8 k0 = as_bf8(ldg16(kT + ks * 16)), k1 = as_bf8(ldg16(kT + (size_t)32 * TK + ks * 16));
            const int sb = ks * 16 + fh * 8;
#pragma unroll
            for (int dir = 0; dir < 2; ++dir) {
                LDSQ const float* ew = s_ew + dir * 128 + sb;
                u32x4 w; w.x = pack2(x[0] * ew[0], x[1] * ew[1]); w.y = pack2(x[2] * ew[2], x[3] * ew[3]); w.z = pack2(x[4] * ew[4], x[5] * ew[5]); w.w = pack2(x[6] * ew[6], x[7] * ew[7]);
                const bf16x8 vf = as_bf8(w);
                acc[dir][0] = mfma32(k0, vf, acc[dir][0]);
                acc[dir][1] = mfma32(k1, vf, acc[dir][1]);
            }
        }
#pragma unroll
        for (int dir = 0; dir < 2; ++dir) {
            float* kv = (float*)(ws + WS::MKV) + (((size_t)dir * NB * 4 + bh) * NCM + cc) * 16384 + (size_t)(vt * 32 + fr) * 128 + kh * 64;
#pragma unroll
            for (int kt = 0; kt < 2; ++kt)
#pragma unroll
                for (int rg = 0; rg < 4; ++rg) *(f32x4*)(kv + kt * 32 + 8 * rg + 4 * fh) = (f32x4){acc[dir][kt][4 * rg], acc[dir][kt][4 * rg + 1], acc[dir][kt][4 * rg + 2], acc[dir][kt][4 * rg + 3]};
        }
    }
    {
        const int k = tid & 127, part = tid >> 7;
        const bf16_t* kk = (const bf16_t*)(ws + WS::MK) + ((size_t)bh * TK + pos0 + part * 32) * 128 + k;
        float a0 = 0.f, a1 = 0.f;
        for (int s2 = 0; s2 < 32; ++s2) { const float kvl = bf2f(kk[(size_t)s2 * 128]); a0 += s_ew[part * 32 + s2] * kvl; a1 += s_ew[128 + part * 32 + s2] * kvl; }
        s_part[part * 128 + k] = a0; s_part[512 + part * 128 + k] = a1;
    }
    __syncthreads();
    if (tid < 256) {
        const int dir = tid >> 7, k = tid & 127;
        const size_t o = ((size_t)dir * NB * 4 + bh) * NCM + cc;
        LDSQ const float* pp = s_part + dir * 512;
        ((float*)(ws + WS::MKS))[o * 128 + k] = pp[k] + pp[128 + k] + pp[256 + k] + pp[384 + k];
        if (k == 0) { float* gm = (float*)(ws + WS::MGM) + o * 4; gm[0] = s_x[8 + dir]; gm[1] = s_x[10 + dir]; }
    }
    __syncthreads();
}
DEV void ml_scan(const Ctx& c) {
    unsigned char* ws = c.p.ws;
    LDSQ float* s_a = (LDSQ float*)c.smem; LDSQ float* s_e = s_a + NCM;
    const int tid = TIDX;
    for (int blk = c.bid; blk < 2 * NB * 4 * 8; blk += c.nblk) {
        const int combo = blk >> 3, e4 = (blk & 7) * NTHR + tid, dir = combo / (NB * 4);
        float* gm = (float*)(ws + WS::MGM) + (size_t)combo * NCM * 4;
        if (tid == 0) {
            float m = 0.f;
            for (int j = 0; j < NCM; ++j) {
                const int cc = ml_order(dir, j);
                const float g = gm[cc * 4], mw = gm[cc * 4 + 1];
                if ((blk & 7) == 0) gm[cc * 4 + 2] = m;
                const float mn = fmaxf(g + m, mw);
                s_a[j] = fexp(g + m - mn); s_e[j] = fexp(mw - mn); m = mn;
            }
        }
        __syncthreads();
        const float* __restrict__ kv = (const float*)(ws + WS::MKV) + (size_t)combo * NCM * 16384 + e4 * 4;
        bf16_t* __restrict__ c0 = (bf16_t*)(ws + WS::MC0) + (size_t)combo * NCM * 16384 + e4 * 4;
        const float* __restrict__ ksv = (const float*)(ws + WS::MKS) + (size_t)combo * NCM * 128 + e4 * 4;
        float* __restrict__ n0 = (float*)(ws + WS::MN0) + (size_t)combo * NCM * 128 + e4 * 4;
        f32x4 C = (f32x4){0.f, 0.f, 0.f, 0.f}, n = C;
        const f32x4 z4 = (f32x4){0.f, 0.f, 0.f, 0.f};
        f32x4 pre[4], p1[4], p2[4], nxt[4];
#pragma unroll
        for (int u = 0; u < 4; ++u) {
            pre[u] = u < NCM ? *(const f32x4*)(kv + (size_t)ml_order(dir, u) * 16384) : z4;
            p1[u] = 4 + u < NCM ? *(const f32x4*)(kv + (size_t)ml_order(dir, 4 + u) * 16384) : z4;
            p2[u] = 8 + u < NCM ? *(const f32x4*)(kv + (size_t)ml_order(dir, 8 + u) * 16384) : z4;
        }
#pragma unroll 1
        for (int j0 = 0; j0 < NCM; j0 += 4) {
#pragma unroll
            for (int u = 0; u < 4; ++u) nxt[u] = (j0 + 12 + u < NCM) ? *(const f32x4*)(kv + (size_t)ml_order(dir, j0 + 12 + u) * 16384) : z4;
#pragma unroll
            for (int u = 0; u < 4; ++u) {
                const int j = j0 + u;
                if (j < NCM) {
                    const int cc = ml_order(dir, j);
                    st_bf4(c0 + (size_t)cc * 16384, C);
                    const float a = s_a[j], e = s_e[j];
                    if (e4 < 32) { *(f32x4*)(n0 + (size_t)cc * 128) = n; n = n * a + *(const f32x4*)(ksv + (size_t)cc * 128) * e; }
                    C = C * a + pre[u] * e;
                }
            }
#pragma unroll
            for (int u = 0; u < 4; ++u) { pre[u] = p1[u]; p1[u] = p2[u]; p2[u] = nxt[u]; }
        }
        __syncthreads();
    }
}
constexpr int ML_KS = 0, ML_VS = 128 * 272, ML_CS = 2 * 128 * 272, ML_QS = 3 * 128 * 272, ML_TAB = 4 * 128 * 272;
DEV void ml_out_item(const Ctx& c, int it) {
    unsigned char* ws = c.p.ws;
    const int tid = TIDX, lane = tid & 63, wave = tid >> 6, fr = lane & 31, fh = lane >> 5, tt = wave >> 1, vh = wave & 1;
    const int cc = it % NCM, bh = it / NCM, b = bh >> 2, head = bh & 3, pos0 = cc * MLC;
    LDSQ float* tab = (LDSQ float*)(c.smem + ML_TAB);
    {
        const bf16_t* mk = (const bf16_t*)(ws + WS::MK) + ((size_t)bh * TK + pos0) * 128;
        const bf16_t* mvt = (const bf16_t*)(ws + WS::MVT) + (size_t)bh * 128 * TK + pos0;
        const bf16_t* mq = (const bf16_t*)(ws + WS::MQ) + ((size_t)bh * TK + pos0) * 128;
#pragma unroll
        for (int i = 0; i < 4; ++i) {
            const int chunk = tid + NTHR * i, r = chunk >> 4, cc16 = chunk & 15;
            lds_st16(c.smem + ML_KS + r * 272 + cc16 * 16, ldg16(mk + (size_t)r * 128 + cc16 * 8));
            lds_st16(c.smem + ML_QS + r * 272 + cc16 * 16, ldg16(mq + (size_t)r * 128 + cc16 * 8));
            const u32x4 v = ldg16(mvt + (size_t)r * TK + cc16 * 8);
            const int q = cc16 >> 1, a = cc16 & 1;
            *(LDSQ u32x2*)(c.smem + ML_VS + r * 272 + (16 * q + 4 * a) * 2) = (u32x2){v.x, v.y};
            *(LDSQ u32x2*)(c.smem + ML_VS + r * 272 + (16 * q + 8 + 4 * a) * 2) = (u32x2){v.z, v.w};
        }
    }
    u32x4 c0r[4];
    {
        const bf16_t* c0g = (const bf16_t*)(ws + WS::MC0) + (((size_t)0 * NB * 4 + bh) * NCM + cc) * 16384;
#pragma unroll
        for (int i = 0; i < 4; ++i) { const int chunk = tid + NTHR * i; c0r[i] = ldg16(c0g + (size_t)(chunk >> 4) * 128 + (chunk & 15) * 8); }
        const int dir = (tid >> 7) & 1;
        float lfv = 0.f, igv = 0.f;
        if (tid < 256) { const size_t o = ((size_t)dir * NB * 4 + bh) * TK + pos0 + (tid & 127); lfv = ((const float*)(ws + WS::MLF))[o]; igv = ((const float*)(ws + WS::MIG))[o]; }
        float inc = wave_incl_scan_f(lfv);
        if (tid < 256 && lane == 63) tab[896 + wave] = inc;
        __syncthreads();
        if (tid < 256) {
            const float lo = tab[896 + 2 * dir], hi = tab[897 + 2 * dir];
            if (wave & 1) inc += lo;
            tab[tid] = dir == 0 ? inc : (lo + hi) - (inc - lfv);
            tab[256 + tid] = igv;
        }
    }
    __syncthreads();
    lds_t qb = c.smem + ML_QS + (tt * 32 + fr) * 272 + fh * 16;
    f32x16 S[4];
#pragma unroll
    for (int st = 0; st < 4; ++st) {
#pragma unroll
        for (int r = 0; r < 16; ++r) S[st][r] = 0.f;
#pragma unroll
        for (int ks = 0; ks < 8; ++ks) S[st] = mfma32(as_bf8(lds_ld16(c.smem + ML_KS + (32 * st + fr) * 272 + (2 * ks + fh) * 16)), as_bf8(lds_ld16(qb + ks * 32)), S[st]);
    }
    f32x16 hs[2];
#pragma unroll
    for (int r = 0; r < 16; ++r) { hs[0][r] = 0.f; hs[1][r] = 0.f; }
    const int t = tt * 32 + fr;
#pragma unroll 1
    for (int dir = 0; dir < 2; ++dir) {
        const size_t so = ((size_t)dir * NB * 4 + bh) * NCM + cc;
        __syncthreads();
        {
#pragma unroll
            for (int i = 0; i < 4; ++i) { const int chunk = tid + NTHR * i, r = chunk >> 4, cc16 = chunk & 15; lds_st16(c.smem + ML_CS + r * 272 + cc16 * 16, c0r[i]); }
            if (tid < 128) tab[512 + tid] = ((const float*)(ws + WS::MN0))[so * 128 + tid];
            if (dir == 0) {
                const bf16_t* c0g = (const bf16_t*)(ws + WS::MC0) + (((size_t)1 * NB * 4 + bh) * NCM + cc) * 16384;
#pragma unroll
                for (int i = 0; i < 4; ++i) { const int chunk = tid + NTHR * i; c0r[i] = ldg16(c0g + (size_t)(chunk >> 4) * 128 + (chunk & 15) * 8); }
            }
        }
        __syncthreads();
        const float m0 = ((const float*)(ws + WS::MGM))[so * 4 + 2];
        const float cumt = tab[dir * 128 + t], inter = cumt + m0;
        float mx = inter;
#pragma unroll
        for (int st = 0; st < 4; ++st)
#pragma unroll
            for (int r = 0; r < 16; ++r) {
                const int s2 = 32 * st + (r & 3) + 8 * (r >> 2) + 4 * fh;
                const bool ok = dir == 0 ? s2 <= t : s2 >= t;
                const float d = cumt - tab[dir * 128 + s2] + tab[256 + dir * 128 + s2];
                mx = ok ? fmaxf(mx, d) : mx;
            }
        mx = fmaxf(mx, __shfl_xor(mx, 32));
        const float ei = fexp(inter - mx);
        f32x16 acc[2];
#pragma unroll
        for (int r = 0; r < 16; ++r) { acc[0][r] = 0.f; acc[1][r] = 0.f; }
        float nq = 0.f;
#pragma unroll
        for (int ks = 0; ks < 8; ++ks) {
            const bf16x8 qk = as_bf8(lds_ld16(qb + ks * 32));
            acc[0] = mfma32(as_bf8(lds_ld16(c.smem + ML_CS + (64 * vh + fr) * 272 + (2 * ks + fh) * 16)), qk, acc[0]);
            acc[1] = mfma32(as_bf8(lds_ld16(c.smem + ML_CS + (64 * vh + 32 + fr) * 272 + (2 * ks + fh) * 16)), qk, acc[1]);
#pragma unroll
            for (int e = 0; e < 8; ++e) nq += tab[512 + ks * 16 + fh * 8 + e] * bf2f((bf16_t)qk[e]);
        }
        nq += __shfl_xor(nq, 32);
#pragma unroll
        for (int r = 0; r < 16; ++r) { acc[0][r] *= ei; acc[1][r] *= ei; }
        float den = 0.f;
#pragma unroll
        for (int st = 0; st < 4; ++st) {
            float w[16];
#pragma unroll
            for (int r = 0; r < 16; ++r) {
                const int s2 = 32 * st + (r & 3) + 8 * (r >> 2) + 4 * fh;
                const bool ok = dir == 0 ? s2 <= t : s2 >= t;
                const float d = cumt - tab[dir * 128 + s2] + tab[256 + dir * 128 + s2];
                w[r] = ok ? fexp(d - mx) * S[st][r] : 0.f;
                den += w[r];
            }
#pragma unroll
            for (int k2 = 0; k2 < 2; ++k2) {
                u32x4 pw; pw.x = pack2(w[8 * k2], w[8 * k2 + 1]); pw.y = pack2(w[8 * k2 + 2], w[8 * k2 + 3]); pw.z = pack2(w[8 * k2 + 4], w[8 * k2 + 5]); pw.w = pack2(w[8 * k2 + 6], w[8 * k2 + 7]);
                const bf16x8 pf = as_bf8(pw);
                acc[0] = mfma32(as_bf8(lds_ld16(c.smem + ML_VS + (64 * vh + fr) * 272 + (4 * st + 2 * k2 + fh) * 16)), pf, acc[0]);
                acc[1] = mfma32(as_bf8(lds_ld16(c.smem + ML_VS + (64 * vh + 32 + fr) * 272 + (4 * st + 2 * k2 + fh) * 16)), pf, acc[1]);
            }
        }
        den += __shfl_xor(den, 32);
        den += ei * nq;
        const float rd = 1.0f / fmaxf(fabsf(den), fexp(-mx));
#pragma unroll
        for (int r = 0; r < 16; ++r) { hs[0][r] += acc[0][r] * rd; hs[1][r] += acc[1][r] * rd; }
    }
    {
        const int row = bpos_row(b, pos0 + t);
        const bf16_t* po = (const bf16_t*)(ws + WS::PBUF) + (size_t)row * LDP + 3584 + head * 128;
        bf16_t* yc = (bf16_t*)(ws + WS::YC) + (size_t)row * 512 + head * 128;
#pragma unroll
        for (int vt = 0; vt < 2; ++vt)
#pragma unroll
            for (int rg = 0; rg < 4; ++rg) {
                const int v = 64 * vh + 32 * vt + 8 * rg + 4 * fh;
                const u32x2 og = *(const u32x2*)(po + v);
                f32x4 y;
                y[0] = hs[vt][4 * rg] * sigmoidf_(__uint_as_float(og.x << 16)); y[1] = hs[vt][4 * rg + 1] * sigmoidf_(__uint_as_float(og.x & 0xffff0000u));
                y[2] = hs[vt][4 * rg + 2] * sigmoidf_(__uint_as_float(og.y << 16)); y[3] = hs[vt][4 * rg + 3] * sigmoidf_(__uint_as_float(og.y & 0xffff0000u));
                st_bf4(yc + v, y);
            }
    }
    __syncthreads();
}

template <class G> DEV void branch_tile(const Ctx& c, int m0, int n0) {
    unsigned char* ws = c.p.ws;
    const bf16_t* P = (const bf16_t*)(ws + WS::PBUF); bf16_t* mixed = (bf16_t*)(ws + WS::MIXED);
    {
        constexpr int CPR = G::BN / 8, NCHK = G::BM * CPR / NTHR, RSF = G::BN * 4 + 16;
        f32x4 ta[NCHK], tb[NCHK];
#pragma unroll
        for (int q = 0; q < NCHK; ++q) { ta[q] = (f32x4){0.f, 0.f, 0.f, 0.f}; tb[q] = ta[q]; }
        const int tid = TIDX;
#pragma unroll 1
        for (int i = 0; i < 3; ++i) {
            const bf16_t* Y = (const bf16_t*)(ws + WS::YA + (size_t)i * WS::Y_SZ);
            const bf16_t* Bt = (const bf16_t*)(ws + WS::WBR + (size_t)c.par * WS::WSET) + (size_t)i * D * 512;
            f32x4 acc[G::MI][G::NI]; zero_acc<G>(acc);
            gemm_acc<G, false, 0, false>(acc, [=](int m) { return Y + (size_t)m * 512; }, Bt, 512, m0, n0, 512, c.smem);
            {
                const int lane = tid & 63, wave = tid >> 6, wm = wave / G::WN, wn = wave % G::WN;
#pragma unroll
                for (int mi = 0; mi < G::MI; ++mi)
#pragma unroll
                    for (int ni = 0; ni < G::NI; ++ni)
                        *(LDSQ f32x4*)(c.smem + (wm * 32 * G::MT + mi * 16 + (lane & 15)) * RSF + (wn * 32 * G::NT + ni * 16 + 4 * (lane >> 4)) * 4) = acc[mi][ni];
            }
            __syncthreads();
#pragma unroll
            for (int q = 0; q < NCHK; ++q) {
                const int id = tid + NTHR * q, rl = id / CPR, cc = id % CPR;
                f32x4 ga, gb; unpack8f(ldg16(P + (size_t)(m0 + rl) * LDP + 4096 + i * D + n0 + cc * 8), ga, gb);
                const f32x4 a = *(LDSQ const f32x4*)(c.smem + rl * RSF + cc * 32), bq = *(LDSQ const f32x4*)(c.smem + rl * RSF + cc * 32 + 16);
#pragma unroll
                for (int e = 0; e < 4; ++e) { ta[q][e] += sigmoidf_(ga[e]) * a[e]; tb[q][e] += sigmoidf_(gb[e]) * bq[e]; }
#ifndef EMU
                if (q & 1) __builtin_amdgcn_sched_barrier(0);
#endif
            }
            __syncthreads();
        }
#pragma unroll
        for (int q = 0; q < NCHK; ++q) { const int id = tid + NTHR * q, rl = id / CPR, cc = id % CPR; *(u32x4*)(mixed + (size_t)(m0 + rl) * D + n0 + cc * 8) = pack8f(ta[q], tb[q]); }
    }
}
constexpr int GM_LT = (RL / 256) * (D / 128), GM_CT = (RC / 64) * (D / 256);
DEV void phase_branch(const Ctx& c) {
    for (int rnd = 0;; ++rnd) {
        const int it = perm_slot(rnd, c.bid, c.nblk);
        if (it >= GM_LT + GM_CT) break;
        if (it < GM_LT) { int mt, nt; grouped_tile(it, RL / 256, D / 128, mt, nt); branch_tile<GMid>(c, mt * 256, nt * 128); }
        else { const int j = it - GM_LT; branch_tile<GSmall>(c, RL + (j % (RC / 64)) * 64, (j / (RC / 64)) * 256); }
    }
}
template <class G> DEV void out_tile(const Ctx& c, int l, int m0, int n0) {
    unsigned char* ws = c.p.ws;
    const bf16_t* A = (const bf16_t*)(ws + WS::MIXED); const bf16_t* Bt = (const bf16_t*)(ws + WS::WOUT + (size_t)c.par * WS::WSET);
    float* xc = (float*)(ws + WS::XCUR); const float* modv = (const float*)(ws + WS::MODV) + (size_t)l * 3 * 6 * D;
    f32x4 acc[G::MI][G::NI]; zero_acc<G>(acc);
    gemm_acc<G>(acc, [=](int m) { return A + (size_t)m * D; }, Bt, D, m0, n0, D, c.smem);
    epi_lds_f32<G>(acc, m0, n0, c.smem, [=](int row, int col, f32x4 a, f32x4 bq) {
        const float* gp = modv + (size_t)row_cond(row) * 6 * D + 2 * D + col;
        f32x4* xp = (f32x4*)(xc + (size_t)row * D + col);
        xp[0] = xp[0] + *(const f32x4*)gp * a; xp[1] = xp[1] + *(const f32x4*)(gp + 4) * bq;
    });
}
DEV void phase_out(const Ctx& c, int l) {
    for (int rnd = 0;; ++rnd) {
        const int it = perm_slot(rnd, c.bid, c.nblk);
        if (it >= GM_LT + GM_CT) break;
        if (it < GM_LT) { int mt, nt; grouped_tile(it, RL / 256, D / 128, mt, nt); out_tile<GMid>(c, l, mt * 256, nt * 128); }
        else { const int j = it - GM_LT; out_tile<GSmall>(c, l, RL + (j % (RC / 64)) * 64, (j / (RC / 64)) * 256); }
    }
}
DEV void phase_norm2_router(const Ctx& c, int l) {
    const int tid = TIDX, lane = tid & 63, wave = tid >> 6;
    const float* xc = (const float*)(c.p.ws + WS::XCUR);
    bf16_t* dst = (bf16_t*)(c.p.ws + WS::A1);
    const float* modv = (const float*)(c.p.ws + WS::MODV) + (size_t)l * 3 * 6 * D;
    const float* wr = c.p.in[I_WR] + (size_t)l * D * NE;
    float* aff = (float*)(c.p.ws + WS::AFF);
    constexpr int NV = D / 256;
    for (int idx = tid; idx < D * 4; idx += NTHR) {
        const int k = idx >> 2, e4 = idx & 3, kk = ((k >> 8) * 4 + (k & 3)) * 64 + ((k & 255) >> 2);
        *(LDSQ f32x4*)(c.smem + kk * 80 + e4 * 16) = *(const f32x4*)(wr + (size_t)k * NE + e4 * 4);
    }
    __syncthreads();
    const int stride = c.nblk * 8;
    int row = c.bid * 8 + wave;
    f32x4 cur[NV], nxt[NV];
    if (row < R) {
#pragma unroll
        for (int i = 0; i < NV; ++i) cur[i] = *(const f32x4*)(xc + (size_t)row * D + i * 256 + lane * 4);
    }
    for (; row < R; row += stride) {
        const int nrow = row + stride;
        if (nrow < R) {
#pragma unroll
            for (int i = 0; i < NV; ++i) nxt[i] = *(const f32x4*)(xc + (size_t)nrow * D + i * 256 + lane * 4);
        }
        float ss = 0.f;
#pragma unroll
        for (int i = 0; i < NV; ++i) ss += cur[i][0] * cur[i][0] + cur[i][1] * cur[i][1] + cur[i][2] * cur[i][2] + cur[i][3] * cur[i][3];
        ss = wave_sum(ss);
        const float inv = 1.0f / sqrtf(ss * (1.0f / D) + EPS);
        const float* mv = modv + (size_t)row_cond(row) * 6 * D + 3 * D;
        float v[16];
#pragma unroll
        for (int e = 0; e < 16; ++e) v[e] = 0.f;
#pragma unroll
        for (int i = 0; i < NV; ++i) {
            const int col = i * 256 + lane * 4;
            const f32x4 h = cur[i] * inv * (*(const f32x4*)(mv + D + col) + 1.0f) + *(const f32x4*)(mv + col);
            st_bf4(dst + (size_t)row * D + col, h);
#pragma unroll
            for (int q = 0; q < 4; ++q) {
                lds_t wp = c.smem + ((i * 4 + q) * 64 + lane) * 80;
#pragma unroll
                for (int e4 = 0; e4 < 4; ++e4) { const f32x4 w4 = *(LDSQ const f32x4*)(wp + e4 * 16); v[e4 * 4] += h[q] * w4[0]; v[e4 * 4 + 1] += h[q] * w4[1]; v[e4 * 4 + 2] += h[q] * w4[2]; v[e4 * 4 + 3] += h[q] * w4[3]; }
            }
        }
#pragma unroll
        for (int j = 0; j < 8; ++j) { const bool hi = (lane & 32) != 0; const float send = hi ? v[j] : v[j + 8], keep = hi ? v[j + 8] : v[j]; v[j] = keep + __shfl_xor(send, 32); }
#pragma unroll
        for (int j = 0; j < 4; ++j) { const bool hi = (lane & 16) != 0; const float send = hi ? v[j] : v[j + 4], keep = hi ? v[j + 4] : v[j]; v[j] = keep + __shfl_xor(send, 16); }
#pragma unroll
        for (int j = 0; j < 2; ++j) { const bool hi = (lane & 8) != 0; const float send = hi ? v[j] : v[j + 2], keep = hi ? v[j + 2] : v[j]; v[j] = keep + __shfl_xor(send, 8); }
        { const bool hi = (lane & 4) != 0; const float send = hi ? v[0] : v[1], keep = hi ? v[1] : v[0]; v[0] = keep + __shfl_xor(send, 4); }
        float lg = v[0]; lg += __shfl_xor(lg, 1); lg += __shfl_xor(lg, 2);
        float mx = lg; mx = fmaxf(mx, __shfl_xor(mx, 4)); mx = fmaxf(mx, __shfl_xor(mx, 8)); mx = fmaxf(mx, __shfl_xor(mx, 16)); mx = fmaxf(mx, __shfl_xor(mx, 32));
        const float ex = expf(lg - mx);
        float sm = ex; sm += __shfl_xor(sm, 4); sm += __shfl_xor(sm, 8); sm += __shfl_xor(sm, 16); sm += __shfl_xor(sm, 32);
        int b, pos; row_bpos(row, b, pos);
        const int e = ((lane >> 5) & 1) * 8 + ((lane >> 4) & 1) * 4 + ((lane >> 3) & 1) * 2 + ((lane >> 2) & 1);
        if ((lane & 3) == 0) aff[((size_t)b * NE + e) * TK + pos] = ex / sm;
#pragma unroll
        for (int i = 0; i < NV; ++i) cur[i] = nxt[i];
    }
    __syncthreads();
}
DEV unsigned wave_excl_scan(unsigned v, unsigned& total) {
    const int lane = TIDX & 63;
    unsigned x = v;
#pragma unroll
    for (int d = 1; d < 64; d <<= 1) { const unsigned y = __shfl_up(x, d); if (lane >= d) x += y; }
    total = __shfl(x, 63);
    return x - v;
}
DEV void phase_topk(const Ctx& c) {
    unsigned char* ws = c.p.ws;
    const int tid = TIDX, lane = tid & 63, wave = tid >> 6;
    LDSQ unsigned* hist = (LDSQ unsigned*)c.smem;
    LDSQ unsigned* sh = (LDSQ unsigned*)(c.smem + 1024);
    int* selrow = (int*)(ws + WS::SELROW); float* selaff = (float*)(ws + WS::SELAFF); int* tokslot = (int*)(ws + WS::TOKSLOT);
    constexpr int EL = T / NTHR;
    static_assert(T % NTHR == 0 && TC <= NTHR, "top-k element ownership");
    for (int it = c.bid; it < 2 * NB * NE; it += c.nblk) {
        const int seg = it / (NB * NE), b = (it / NE) % NB, e = it % NE;
        const int n = seg ? TC : T, cap = seg ? CAPC : CAPL, pos_off = seg ? 0 : TC, ne = seg ? 1 : EL, i0 = tid * ne;
        const float* av = (const float*)(ws + WS::AFF) + ((size_t)b * NE + e) * TK + pos_off;
        unsigned key[EL];
        if (seg == 0) {
            if constexpr (EL % 4 == 0) {
#pragma unroll
                for (int q = 0; q < EL / 4; ++q) { const u32x4 w = *(const u32x4*)(av + i0 + 4 * q); key[4 * q] = w.x; key[4 * q + 1] = w.y; key[4 * q + 2] = w.z; key[4 * q + 3] = w.w; }
            } else {
#pragma unroll
                for (int q = 0; q < EL; ++q) key[q] = __float_as_uint(av[i0 + q]);
            }
        } else {
#pragma unroll
            for (int q = 0; q < EL; ++q) key[q] = 0u;
            if (tid < n) key[0] = __float_as_uint(av[tid]);
        }
        const bool act = i0 < n;
        unsigned prefix = 0u, remaining = (unsigned)cap;
#pragma unroll 1
        for (int pass = 0; pass < 4; ++pass) {
            const int shift = 24 - 8 * pass;
            if (tid < 256) hist[tid] = 0u;
            __syncthreads();
            const unsigned himask = pass == 0 ? 0u : (0xffffffffu << (shift + 8));
            if (act) {
#pragma unroll
                for (int q = 0; q < EL; ++q) if (q < ne && (key[q] & himask) == prefix) lds_inc(&hist[(key[q] >> shift) & 255u]);
            }
            __syncthreads();
            unsigned hv = tid < 256 ? hist[255 - tid] : 0u, tot;
            const unsigned ex = wave_excl_scan(hv, tot);
            if (lane == 0) sh[wave] = tot;
            __syncthreads();
            unsigned base = 0u;
            for (int w = 0; w < 4; ++w) if (w < wave) base += sh[w];
            const unsigned above = base + ex;
            if (tid < 256 && above < remaining && above + hv >= remaining) { sh[8] = 255u - (unsigned)tid; sh[9] = remaining - above; }
            __syncthreads();
            prefix |= sh[8] << shift; remaining = sh[9];
            __syncthreads();
        }
        const unsigned thr = prefix, need = remaining;
        unsigned ngt = 0u, neq = 0u;
        if (act) {
#pragma unroll
            for (int q = 0; q < EL; ++q) if (q < ne) { ngt += key[q] > thr ? 1u : 0u; neq += key[q] == thr ? 1u : 0u; }
        }
        unsigned tg, te;
        const unsigned xg = wave_excl_scan(ngt, tg), xe = wave_excl_scan(neq, te);
        if (lane == 0) { sh[16 + wave] = tg; sh[24 + wave] = te; }
        __syncthreads();
        unsigned gt_before = xg, eq_before = xe;
        for (int w = 0; w < 8; ++w) if (w < wave) { gt_before += sh[16 + w]; eq_before += sh[24 + w]; }
        const int er0 = seg ? MEL + b * CAPC : b * CAPL;
        if (act) {
            unsigned slot = gt_before + (eq_before < need ? eq_before : need), eqr = eq_before;
#pragma unroll
            for (int q = 0; q < EL; ++q) if (q < ne) {
                const unsigned k = key[q];
                const bool sel = k > thr || (k == thr && eqr < need);
                if (k == thr) ++eqr;
                const int row = bpos_row(b, pos_off + i0 + q);
                if (sel) { const int er = er0 + (int)slot; selrow[e * MEP + er] = row; selaff[e * MEP + er] = __uint_as_float(k); tokslot[(size_t)row * NE + e] = er; ++slot; }
                else tokslot[(size_t)row * NE + e] = -1;
            }
        }
        if (seg == 1 && b == 0) for (int i = MEL + MEC + tid; i < MEP; i += NTHR) { selrow[e * MEP + i] = -1; selaff[e * MEP + i] = 0.f; }
        __syncthreads();
    }
}
template <class G> DEV void moe1_tile(const Ctx& c, int e, int m0, int n0) {
    unsigned char* ws = c.p.ws;
    const bf16_t* h2 = (const bf16_t*)(ws + WS::A1); const int* selrow = (const int*)(ws + WS::SELROW) + e * MEP;
    const bf16_t* Bt = (const bf16_t*)(ws + WS::WGU + (size_t)c.par * WS::WSET) + (size_t)e * 2 * DE * D;
    bf16_t* hid = (bf16_t*)(ws + WS::HID) + (size_t)e * MEP * DE;
    f32x4 acc[G::MI][G::NI]; zero_acc<G>(acc);
    gemm_acc<G, true>(acc, [=](int m) -> const bf16_t* { const int r = selrow[m]; return h2 + (size_t)(r >= 0 ? r : 0) * D; }, Bt, D, m0, n0, D, c.smem);
    constexpr int HN = G::BN / 2, RSE = HN * 2 + 16;
    const int tid = TIDX, lane = tid & 63, wave = tid >> 6, wm = wave / G::WN, wn = wave % G::WN;
#pragma unroll
    for (int mi = 0; mi < G::MI; ++mi) {
        const int rl = wm * 32 * G::MT + mi * 16 + (lane & 15);
#pragma unroll
        for (int np = 0; np < G::NI / 2; ++np) {
            const int hl = (wn * 32 * G::NT) / 2 + np * 16 + 4 * (lane >> 4);
            f32x4 y;
#pragma unroll
            for (int q = 0; q < 4; ++q) y[q] = siluf_(acc[mi][2 * np][q]) * acc[mi][2 * np + 1][q];
            u32x2 w; w.x = pack2(y[0], y[1]); w.y = pack2(y[2], y[3]);
            *(LDSQ u32x2*)(c.smem + rl * RSE + hl * 2) = w;
        }
    }
    __syncthreads();
    constexpr int CPR = HN / 8;
#pragma unroll 4
    for (int id = tid; id < G::BM * CPR; id += NTHR) { const int rl = id / CPR, cc = id % CPR; *(u32x4*)(hid + (size_t)(m0 + rl) * DE + n0 / 2 + cc * 8) = lds_ld16(c.smem + rl * RSE + cc * 16); }
    __syncthreads();
}
template <class G> DEV void moe2_tile(const Ctx& c, int e, int m0, int n0) {
    unsigned char* ws = c.p.ws;
    const bf16_t* hid = (const bf16_t*)(ws + WS::HID) + (size_t)e * MEP * DE; const float* selaff = (const float*)(ws + WS::SELAFF) + e * MEP;
    const bf16_t* Bt = (const bf16_t*)(ws + WS::WDN + (size_t)c.par * WS::WSET) + (size_t)e * D * DE;
    bf16_t* ys = (bf16_t*)(ws + WS::YS) + (size_t)e * MEP * D;
    f32x4 acc[G::MI][G::NI]; zero_acc<G>(acc);
    gemm_acc<G>(acc, [=](int m) { return hid + (size_t)m * DE; }, Bt, DE, m0, n0, DE, c.smem);
    epi_lds_bf16<G>(acc, m0, n0, c.smem, [=](int row, int col, f32x4 v) { return v * selaff[row]; }, [=](int row, int col, u32x4 w) { *(u32x4*)(ys + (size_t)row * D + col) = w; });
}
template <int BM> struct MoeG { typedef GSmall type; };
template <> struct MoeG<256> { typedef GBig type; };
typedef MoeG<MOE_BM>::type GMoe;
constexpr int MOE_LT = MEL / MOE_BM, MOE_CT = (MEP - MEL) / 64;
DEV void phase_moe1(const Ctx& c) {
    constexpr int NNT = 2 * DE / 256, TPE = MOE_LT * NNT, NL_IT = NE * TPE, NC_IT = NE * MOE_CT * NNT;
    for (int rnd = 0;; ++rnd) {
        const int it = perm_slot(rnd, c.bid, c.nblk);
        if (it >= NL_IT + NC_IT) break;
        if (it < NL_IT) { int mt, nt; grouped_tile(it % TPE, MOE_LT, NNT, mt, nt); moe1_tile<GMoe>(c, it / TPE, mt * MOE_BM, nt * 256); }
        else { const int j = it - NL_IT, mt = j % MOE_CT, nt = (j / MOE_CT) % NNT, e = j / (MOE_CT * NNT); moe1_tile<GSmall>(c, e, MEL + mt * 64, nt * 256); }
    }
}
DEV void phase_moe2(const Ctx& c) {
    constexpr int NNT = D / 256, TPE = MOE_LT * NNT, NL_IT = NE * TPE, NC_IT = NE * MOE_CT * NNT;
    for (int rnd = 0;; ++rnd) {
        const int it = perm_slot(rnd, c.bid, c.nblk);
        if (it >= NL_IT + NC_IT) break;
        if (it < NL_IT) { int mt, nt; grouped_tile(it % TPE, MOE_LT, NNT, mt, nt); moe2_tile<GMoe>(c, it / TPE, mt * MOE_BM, nt * 256); }
        else { const int j = it - NL_IT, mt = j % MOE_CT, nt = (j / MOE_CT) % NNT, e = j / (MOE_CT * NNT); moe2_tile<GSmall>(c, e, MEL + mt * 64, nt * 256); }
    }
}
DEV void phase_combine(const Ctx& c, int l) {
    unsigned char* ws = c.p.ws;
    const int tid = TIDX, lane = tid & 63, wave = tid >> 6;
    float* xc = (float*)(ws + WS::XCUR); const float* modv = (const float*)(ws + WS::MODV) + (size_t)l * 3 * 6 * D;
    const int* tokslot = (const int*)(ws + WS::TOKSLOT); const bf16_t* ys = (const bf16_t*)(ws + WS::YS);
    bf16_t* a1 = (bf16_t*)(ws + WS::A1);
    constexpr int NV = D / 256;
    const int stride = c.nblk * 8;
    int row = c.bid * 8 + wave;
    int myslot = -1, nslot = -1;
    f32x4 xv[NV], nx[NV];
    if (row < R) {
        myslot = tokslot[(size_t)row * NE + (lane & 15)];
#pragma unroll
        for (int i = 0; i < NV; ++i) xv[i] = *(const f32x4*)(xc + (size_t)row * D + i * 256 + lane * 4);
    }
    for (; row < R; row += stride, myslot = nslot) {
        const int nrow = row + stride;
        if (nrow < R) {
            nslot = tokslot[(size_t)nrow * NE + (lane & 15)];
#pragma unroll
            for (int i = 0; i < NV; ++i) nx[i] = *(const f32x4*)(xc + (size_t)nrow * D + i * 256 + lane * 4);
        }
        f32x4 acc[NV];
#pragma unroll
        for (int i = 0; i < NV; ++i) acc[i] = (f32x4){0.f, 0.f, 0.f, 0.f};
#pragma unroll 4
        for (int e = 0; e < NE; ++e) {
            const int sl = __shfl(myslot, e);
            if (sl >= 0) {
                const bf16_t* yr = ys + ((size_t)e * MEP + sl) * D;
#pragma unroll
                for (int i = 0; i < NV; ++i) { const u32x2 w = *(const u32x2*)(yr + i * 256 + lane * 4); acc[i][0] += __uint_as_float(w.x << 16); acc[i][1] += __uint_as_float(w.x & 0xffff0000u); acc[i][2] += __uint_as_float(w.y << 16); acc[i][3] += __uint_as_float(w.y & 0xffff0000u); }
            }
        }
        const int cond = row_cond(row);
        const float* g = modv + (size_t)cond * 6 * D + 5 * D;
        float ss = 0.f;
#pragma unroll
        for (int i = 0; i < NV; ++i) {
            const int col = i * 256 + lane * 4;
            xv[i] = xv[i] + *(const f32x4*)(g + col) * acc[i];
            *(f32x4*)(xc + (size_t)row * D + col) = xv[i];
            ss += xv[i][0] * xv[i][0] + xv[i][1] * xv[i][1] + xv[i][2] * xv[i][2] + xv[i][3] * xv[i][3];
        }
        if (l == NL - 1) {
            if (row < RL) {
#pragma unroll
                for (int i = 0; i < NV; ++i) *(f32x4*)(c.p.out + (size_t)row * D + i * 256 + lane * 4) = xv[i];
            }
        } else {
            ss = wave_sum(ss);
            const float inv = 1.0f / sqrtf(ss * (1.0f / D) + EPS);
            const float* mv = modv + 3 * 6 * D + (size_t)cond * 6 * D;
#pragma unroll
            for (int i = 0; i < NV; ++i) {
                const int col = i * 256 + lane * 4;
                st_bf4(a1 + (size_t)row * D + col, xv[i] * inv * (*(const f32x4*)(mv + D + col) + 1.0f) + *(const f32x4*)(mv + col));
            }
        }
#pragma unroll
        for (int i = 0; i < NV; ++i) xv[i] = nx[i];
    }
}

enum { PH_PROLOGUE = 0, PH_CONVERT, PH_NORM1, PH_INPROJ, PH_PREP, PH_MIX1, PH_SCAN, PH_MIX2, PH_GLU, PH_BRANCH, PH_OUT, PH_NORM2, PH_TOPK, PH_MOE1, PH_MOE2, PH_COMBINE, PH_FINAL, PH_COUNT };
#ifdef EMU
int emu_stop_layer = 1 << 30, emu_stop_phase = 1 << 30;
#endif

template <int PH> DEV void run_phase(const Ctx& c, int l) {
    if constexpr (PH == PH_PROLOGUE) { phase_prologue(c); phase_convert(c, 0); phase_s5_tab1(c, 0); }
    if constexpr (PH == PH_NORM1) { if (l == 0) phase_norm(c, 0, 0); if (l == 0 || SCHED_MODE == 1 || SCHED_MODE == 8 || SCHED_MODE == 3 || SCHED_MODE == 6 || SCHED_MODE == 7 || SCHED_MODE == 9 || SCHED_MODE == 10) phase_s5_tab2(c, l); }
    if constexpr (PH == PH_CONVERT) { if (SCHED_MODE == 1 || SCHED_MODE == 8 || SCHED_MODE == 4) { phase_convert(c, l); phase_s5_tab1(c, l); } if (SCHED_MODE == 6 || SCHED_MODE == 10) phase_convert(c, l); if (SCHED_MODE == 7) phase_s5_tab1(c, l); if (SCHED_MODE == 9) { phase_convert(c, l); phase_s5_tab1(c, l); } }
    if constexpr (PH == PH_INPROJ) { phase_inproj(c); if (PROBE_SUB == 10) probe_inproj<0>(c); if (PROBE_SUB == 11) probe_inproj<1>(c); if (PROBE_SUB == 12) probe_inproj<2>(c); if (PROBE_SUB == 13) probe_inproj<3>(c); }
    if constexpr (PH == PH_PREP) phase_prep(c, l);
    if constexpr (PH == PH_MIX1) phase_mix1(c, l);
    if constexpr (PH == PH_SCAN) {
        s5_scan(c); ml_scan(c);
        const int off = c.nblk / 2;
        if (SCHED_MODE == 10 && l + 1 < NL) { Ctx cu{c.p, c.smem, c.bid, c.nblk, (l + 1) & 1}; phase_s5_tab1(cu, l + 1); }
        if (SCHED_MODE == 8 && c.bid >= off) { Ctx cu{c.p, c.smem, c.bid - off, c.nblk - off, l & 1}; phase_s5_tab1(cu, l); }
        if (SCHED_MODE != 1 && SCHED_MODE != 8 && SCHED_MODE != 10 && SCHED_MODE != 4 && l + 1 < NL && c.bid >= off) { Ctx cu{c.p, c.smem, c.bid - off, c.nblk - off, (l + 1) & 1}; if (SCHED_MODE != 6 && SCHED_MODE != 9) phase_convert(cu, l + 1); if (SCHED_MODE != 7) phase_s5_tab1(cu, l + 1); }
    }
    if constexpr (PH == PH_MIX2) { for (int rep = 0; rep < (PROBE_SUB == 4 ? 2 : 1); ++rep) for (int it = c.bid; it < S5_BIG_IT + S5_SM_IT; it += c.nblk) s5_out_item(c, l, it); for (int rep = 0; rep < (PROBE_SUB == 5 ? 2 : 1); ++rep) for (int j = c.bid; j < NB * 4 * (NCM - NCMC); j += c.nblk) ml_out_item(c, (j / (NCM - NCMC)) * NCM + NCMC + (j % (NCM - NCMC))); }
    if constexpr (PH == PH_GLU) phase_glu(c);
    if constexpr (PH == PH_BRANCH) phase_branch(c);
    if constexpr (PH == PH_OUT) phase_out(c, l);
    if constexpr (PH == PH_NORM2) phase_norm2_router(c, l);
    if constexpr (PH == PH_TOPK) {
        phase_topk(c);
        const int off = c.nblk / 4;
        if (SCHED_MODE != 1 && SCHED_MODE != 8 && SCHED_MODE != 3 && SCHED_MODE != 6 && SCHED_MODE != 7 && SCHED_MODE != 9 && SCHED_MODE != 10 && l + 1 < NL && c.bid >= off) { Ctx cu{c.p, c.smem, c.bid - off, c.nblk - off, (l + 1) & 1}; phase_s5_tab2(cu, l + 1); }
    }
    if constexpr (PH == PH_MOE1) phase_moe1(c);
    if constexpr (PH == PH_MOE2) phase_moe2(c);
    if constexpr (PH == PH_COMBINE) phase_combine(c, l);
}

#ifndef EMU
extern __shared__ __attribute__((aligned(16))) unsigned char smem_raw[];
#endif
constexpr int LDS_BYTES = 160 * 1024;

#ifdef EMU
#define GRID_SYNC() emu_grid_sync()
#else
#define GRID_SYNC() do { XcdBarrier bb = bar; asm volatile("" : "+s"(bb.bar), "+s"(bb.x)); xcd_barrier(bb); } while (0)
#endif
#ifdef EMU
#define LAUNDER(kq, ll, bb, nn)
#else
#define LAUNDER(kq, ll, bb, nn) asm volatile("" : "+s"(kq), "+s"(ll), "+s"(bb), "+s"(nn))
#endif
#ifdef EMU
#define PHMARK(PH)
#else
#define PHMARK(PH) asm volatile("; PHASE_MARK %0" :: "n"(PH))
#endif
#ifdef EMU
#define EMU_SKIP(PH, l) if (l > emu_stop_layer || (l == emu_stop_layer && PH > emu_stop_phase)) break;
#else
#define EMU_SKIP(PH, l)
#endif
#define RUN1(PH, l) do { EMU_SKIP(PH, l) PHMARK(PH); auto kq = kp; int ll = l, bb = bid0, nn = nblk0; LAUNDER(kq, ll, bb, nn); Ctx cc{*kq, smem, bb, nn, ll & 1}; run_phase<PH>(cc, ll); GRID_SYNC(); } while (0)
#define RUN(PH, l) do { RUN1(PH, l); if ((PROBE_MASK >> PH) & 1u) RUN1(PH, l); } while (0)
__global__ void __launch_bounds__(NTHR, 2) k_mega(Params p) {
#ifdef EMU
    const Params* kp = &p; lds_t smem = emu_smem();
#else
    const KAS Params* kp = (const KAS Params*)__builtin_amdgcn_kernarg_segment_ptr(); lds_t smem = (lds_t)smem_raw;
    volatile LAS unsigned* xbw = (volatile LAS unsigned*)(smem_raw + LDS_BYTES - 16);
    if (threadIdx.x == 0) { xbw[0] = 0u; xbw[1] = 0u; xbw[2] = 0u; xbw[3] = 0u; }
    __syncthreads();
    XcdBarrier bar = xcd_barrier_post((unsigned*)(kp->ws + WS::BAR), xbw);
#endif
    const int bid0 = blockIdx.x, nblk0 = gridDim.x;
    RUN(PH_PROLOGUE, 0); RUN(PH_NORM1, 0);
#pragma unroll 1
    for (int l = 0; l < NL; ++l) {
        if (SCHED_MODE != 0 && l > 0) { RUN(PH_CONVERT, l); RUN(PH_NORM1, l); }
        RUN(PH_INPROJ, l); RUN(PH_PREP, l); RUN(PH_MIX1, l); RUN(PH_SCAN, l); RUN(PH_MIX2, l); RUN(PH_GLU, l);
        RUN(PH_BRANCH, l);
        RUN1(PH_OUT, l);
        RUN(PH_NORM2, l); RUN(PH_TOPK, l); RUN(PH_MOE1, l); RUN(PH_MOE2, l);
        RUN1(PH_COMBINE, l);
    }
}

template <int PH> __global__ void __launch_bounds__(NTHR, 2) k_phase(Params p, int l) {
#ifdef EMU
    Ctx c{p, emu_smem(), (int)blockIdx.x, (int)gridDim.x, l & 1};
#else
    Ctx c{*(const KAS Params*)__builtin_amdgcn_kernarg_segment_ptr(), (lds_t)smem_raw, (int)blockIdx.x, (int)gridDim.x, l & 1};
#endif
    run_phase<PH>(c, l);
}

#ifdef EMU
template <int PH> static void emu_kphase(const void* a) { struct A { Params p; int l; }; const A* x = (const A*)a; k_phase<PH>(x->p, x->l); }
template <int PH> static void launch_phase(const Params& p, int l, int grid, hipStream_t) {
    if (l > emu_stop_layer || (l == emu_stop_layer && PH > emu_stop_phase)) return;
    struct A { Params p; int l; } a{p, l}; emu_launch(emu_kphase<PH>, &a, grid, NTHR, LDS_BYTES);
}
#else
template <int PH> static void launch_phase(const Params& p, int l, int grid, hipStream_t s) {
    static bool attr = false;
    if (!attr) { hipFuncSetAttribute((const void*)k_phase<PH>, hipFuncAttributeMaxDynamicSharedMemorySize, LDS_BYTES); attr = true; }
    hipLaunchKernelGGL(k_phase<PH>, dim3(grid), dim3(NTHR), LDS_BYTES, s, p, l);
}
#endif

extern "C" void kernel_launch(void* const* d_in, const int* in_sizes, int n_in, void* d_out, int out_size, void* d_ws, size_t ws_size, hipStream_t stream) {
    Params p{};
    for (int i = 0; i < N_IN; ++i) p.in[i] = (const float*)d_in[i];
    p.out = (float*)d_out; p.ws = (unsigned char*)d_ws;
#ifdef EMU
    const int grid = 8;
#else
    static int grid = 0;
    if (!grid) { int dev = 0, cus = 0; hipGetDevice(&dev); hipDeviceGetAttribute(&cus, hipDeviceAttributeMultiprocessorCount, dev); grid = cus > 0 ? cus : 256; }
    if (ws_size < WS::TOTAL) { fprintf(stderr, "workspace too small: %zu < %zu\n", ws_size, (size_t)WS::TOTAL); }
#endif
#if MK_FUSED
#ifdef EMU
    emu_launch([](const void* a) { k_mega(*(const Params*)a); }, &p, grid, NTHR, LDS_BYTES);
#else
    static int fgrid = 0;
    if (!fgrid) {
        int per_cu = 0;
        hipFuncSetAttribute((const void*)k_mega, hipFuncAttributeMaxDynamicSharedMemorySize, LDS_BYTES);
        hipOccupancyMaxActiveBlocksPerMultiprocessor(&per_cu, (const void*)k_mega, NTHR, LDS_BYTES);
        fgrid = per_cu >= 1 ? grid : 0;
        if (!fgrid) fprintf(stderr, "k_mega: occupancy query returned %d\n", per_cu);
    }
    hipMemsetAsync(p.ws + WS::BAR, 0, WS::BAR_SZ, stream);
    if (fgrid) hipLaunchKernelGGL(k_mega, dim3(fgrid), dim3(NTHR), LDS_BYTES, stream, p);
#endif
#else
    launch_phase<PH_PROLOGUE>(p, 0, grid, stream);
    launch_phase<PH_NORM1>(p, 0, grid, stream);
    for (int l = 0; l < NL; ++l) {
        launch_phase<PH_INPROJ>(p, l, grid, stream);
        launch_phase<PH_PREP>(p, l, grid, stream);
        launch_phase<PH_MIX1>(p, l, grid, stream);
        launch_phase<PH_SCAN>(p, l, grid, stream);
        launch_phase<PH_MIX2>(p, l, grid, stream);
        launch_phase<PH_GLU>(p, l, grid, stream);
        launch_phase<PH_BRANCH>(p, l, grid, stream);
        launch_phase<PH_OUT>(p, l, grid, stream);
        launch_phase<PH_NORM2>(p, l, grid, stream);
        launch_phase<PH_TOPK>(p, l, grid, stream);
        launch_phase<PH_MOE1>(p, l, grid, stream);
        launch_phase<PH_MOE2>(p, l, grid, stream);
        launch_phase<PH_COMBINE>(p, l, grid, stream);
    }
#endif
}
```

```cpp
#include <hip/hip_runtime.h>
#ifndef EMU
#include <cstdio>
#include <cstdint>
#endif

#ifndef CFG_D
#define CFG_D 1024
#define CFG_SEQ 16384
#define CFG_DEPTH 4
#define CFG_CTX 256
#define CFG_DE 2048
#define CFG_MOE_BM 256
#endif
#ifndef PROBE_MASK
#define PROBE_MASK 0u
#endif
#ifndef PROBE_SUB
#define PROBE_SUB 0
#endif
#ifndef SCHED_MODE
#define SCHED_MODE 1
#endif
#ifndef MK_FUSED
#define MK_FUSED 1
#endif
constexpr int D = CFG_D, NB = 2, T = CFG_SEQ, TC = CFG_CTX, NL = CFG_DEPTH, DE = CFG_DE, NE = 16;
constexpr int RL = NB * T, RC = NB * TC, R = RL + RC;
constexpr int TK = TC + T;
constexpr int DIN = 4112 + 3 * D;
constexpr int LDP = 4096 + 3 * D;
constexpr int NPIN = ((LDP + 16 + 255) / 256) * 256;
constexpr int NTHR = 512;
constexpr float EPS = 1e-6f;
constexpr int S5L = 64, NCH = NB * TK / S5L, NCHB = TK / S5L;
constexpr int MLC = 128, NCM = TK / MLC, NCMC = TC / MLC;
constexpr int CAPL = 2 * T / NE, CAPC = 2 * TC / NE;
constexpr int MOE_BM = CFG_MOE_BM;
constexpr int MEL = NB * CAPL, MEC = NB * CAPC;
constexpr int MEP = MEL + 64 * ((MEC + 63) / 64);
static_assert(R % 256 == 0 && T % 256 == 0 && TC % 256 == 0 && D % 256 == 0 && DE % 256 == 0, "tile divisibility");
static_assert(MEL % MOE_BM == 0, "moe tile");

typedef unsigned short bf16_t;
typedef short bf16x8 __attribute__((ext_vector_type(8)));
typedef float f32x16 __attribute__((ext_vector_type(16)));
typedef float f32x4 __attribute__((ext_vector_type(4)));
typedef unsigned u32x4 __attribute__((ext_vector_type(4)));
typedef unsigned u32x2 __attribute__((ext_vector_type(2)));
#define DEV __device__ __forceinline__
#ifdef EMU
#define LDSQ
#else
#define LDSQ __attribute__((address_space(3)))
#endif
typedef LDSQ unsigned char* lds_t;
#ifdef EMU
#define TIDX ((int)threadIdx.x)
#else
__device__ __forceinline__ int opaque_tid() { int t = threadIdx.x; asm volatile("" : "+v"(t)); return t; }
#define TIDX opaque_tid()
#endif

enum { I_X, I_C, I_CTX, I_CCTX, I_WMOD, I_BMOD, I_WIN, I_QG, I_KG, I_LAMV, I_OG, I_S5LRE, I_S5LIM, I_S5STEP, I_S5BRE, I_S5BIM, I_S5CRE, I_S5CIM,
       I_S5D, I_S5GLU, I_CONVW, I_CONVB, I_IB, I_FB, I_WBR, I_WOUT, I_WR, I_WEG, I_WEU, I_WED, N_IN };
struct Params { const float* in[N_IN]; float* out; unsigned char* ws; };

constexpr size_t ws_al(size_t x) { return (x + 255) & ~size_t(255); }
struct WS {
    static constexpr size_t BAR = 0,                         BAR_SZ = ws_al(4096 * 4);
    static constexpr size_t MODV = BAR + BAR_SZ,             MODV_SZ = ws_al((size_t)NL * 3 * 6 * D * 4);
    static constexpr size_t ROPE = MODV + MODV_SZ,           ROPE_SZ = ws_al((size_t)(T / 64 + 64) * 16 * 2 * 4);
    static constexpr size_t XCUR = ROPE + ROPE_SZ,           XCUR_SZ = ws_al((size_t)R * D * 4);
    static constexpr size_t A1 = XCUR + XCUR_SZ,             A1_SZ = ws_al((size_t)R * D * 2);
    static constexpr size_t WIN = A1 + A1_SZ,                WIN_SZ = ws_al((size_t)NPIN * D * 2);
    static constexpr size_t WGLU = WIN + WIN_SZ,             WGLU_SZ = ws_al((size_t)512 * 512 * 2);
    static constexpr size_t WBR = WGLU + WGLU_SZ,            WBR_SZ = ws_al((size_t)3 * D * 512 * 2);
    static constexpr size_t WOUT = WBR + WBR_SZ,             WOUT_SZ = ws_al((size_t)D * D * 2);
    static constexpr size_t WGU = WOUT + WOUT_SZ,            WGU_SZ = ws_al((size_t)NE * 2 * DE * D * 2);
    static constexpr size_t WDN = WGU + WGU_SZ,              WDN_SZ = ws_al((size_t)NE * D * DE * 2);
    static constexpr size_t WSET = WIN_SZ + WGLU_SZ + WBR_SZ + WOUT_SZ + WGU_SZ + WDN_SZ;
    static constexpr size_t GATES = WDN + WDN_SZ + WSET,            GATES_SZ = ws_al((size_t)R * 16 * 4);
    static constexpr size_t QP = GATES + GATES_SZ,           QP_SZ = ws_al((size_t)NB * 4 * TK * 128 * 2);
    static constexpr size_t KP = QP + QP_SZ,                 KP_SZ = QP_SZ;
    static constexpr size_t VT = KP + KP_SZ,                 VT_SZ = QP_SZ;
    static constexpr size_t YA = VT + VT_SZ,                 Y_SZ = ws_al((size_t)R * 512 * 2);
    static constexpr size_t YB = YA + Y_SZ;
    static constexpr size_t YC = YB + Y_SZ;
    static constexpr size_t YG = YC + Y_SZ;
    static constexpr size_t MIXED = YG + Y_SZ,               MIXED_SZ = ws_al((size_t)R * D * 2);
    static constexpr size_t UG = MIXED + MIXED_SZ,           UG_SZ = ws_al((size_t)32 * NCH * 1280 * 2);
    static constexpr size_t SLOC = UG + UG_SZ,               SLOC_SZ = ws_al((size_t)32 * NCH * 256 * 4);
    static constexpr size_t S5MIN = SLOC + SLOC_SZ,          S5MIN_SZ = ws_al((size_t)32 * 256 * 1024 * 2);
    static constexpr size_t S5TOEP = S5MIN + S5MIN_SZ,       S5TOEP_SZ = ws_al((size_t)32 * 1024 * 1280 * 2);
    static constexpr size_t S5A64 = S5TOEP + S5TOEP_SZ,      S5A64_SZ = ws_al((size_t)2 * 2 * 32 * 64 * 2 * 4);
    static constexpr size_t S5KT = S5A64 + S5A64_SZ,         S5KT_SZ = ws_al((size_t)32 * 2 * 64 * 256 * 4);
    static constexpr size_t MQ = S5KT + S5KT_SZ,             MQ_SZ = ws_al((size_t)NB * 4 * TK * 128 * 2);
    static constexpr size_t MK = MQ + MQ_SZ;
    static constexpr size_t MKT = MK + MQ_SZ;
    static constexpr size_t MVT = MKT + MQ_SZ;
    static constexpr size_t MIG = MVT + MQ_SZ,               MIG_SZ = ws_al((size_t)2 * NB * 4 * TK * 4);
    static constexpr size_t MLF = MIG + MIG_SZ;
    static constexpr size_t MKV = MLF + MIG_SZ,              MKV_SZ = ws_al((size_t)2 * NB * 4 * NCM * 128 * 128 * 4);
    static constexpr size_t MKS = MKV + MKV_SZ,              MKS_SZ = ws_al((size_t)2 * NB * 4 * NCM * 128 * 4);
    static constexpr size_t MGM = MKS + MKS_SZ,              MGM_SZ = ws_al((size_t)2 * NB * 4 * NCM * 4 * 4);
    static constexpr size_t MC0 = MGM + MGM_SZ,              MC0_SZ = ws_al((size_t)2 * NB * 4 * NCM * 128 * 128 * 2);
    static constexpr size_t MN0 = MC0 + MC0_SZ,              MN0_SZ = MKS_SZ;
    static constexpr size_t AFF = MN0 + MN0_SZ,              AFF_SZ = ws_al((size_t)NB * NE * TK * 4);
    static constexpr size_t SELROW = AFF + AFF_SZ,           SEL_SZ = ws_al((size_t)NE * MEP * 4);
    static constexpr size_t SELAFF = SELROW + SEL_SZ;
    static constexpr size_t TOKSLOT = SELAFF + SEL_SZ,       TOKSLOT_SZ = ws_al((size_t)R * NE * 4);
    static constexpr size_t PBUF = TOKSLOT + TOKSLOT_SZ,     PBUF_SZ = ws_al((size_t)R * LDP * 2);
    static constexpr size_t HID = PBUF,                      HID_SZ = ws_al((size_t)NE * MEP * DE * 2);
    static constexpr size_t YS = HID + HID_SZ,               YS_SZ = ws_al((size_t)NE * MEP * D * 2);
    static constexpr size_t END0 = PBUF + PBUF_SZ, END1 = YS + YS_SZ;
    static constexpr size_t TOTAL = END0 > END1 ? END0 : END1;
};

DEV float bf2f(bf16_t v) { return __uint_as_float(((unsigned)v) << 16); }
DEV bf16_t f2bf(float f) { unsigned u = __float_as_uint(f); u += 0x7fffu + ((u >> 16) & 1u); return (bf16_t)(u >> 16); }
DEV unsigned pack2(float lo, float hi) {
#ifdef EMU
    return (unsigned)f2bf(lo) | ((unsigned)f2bf(hi) << 16);
#else
    unsigned r; asm("v_cvt_pk_bf16_f32 %0, %1, %2" : "=v"(r) : "v"(lo), "v"(hi)); return r;
#endif
}
DEV float fexp2(float x) {
#ifdef EMU
    return exp2f(x);
#else
    return __builtin_amdgcn_exp2f(x);
#endif
}
DEV float fexp(float x) { return fexp2(x * 1.44269504089f); }
DEV float frcp(float x) {
#ifdef EMU
    return 1.0f / x;
#else
    return __builtin_amdgcn_rcpf(x);
#endif
}
DEV float sigmoidf_(float x) { return frcp(1.0f + fexp(-x)); }
DEV float siluf_(float x) { return x * sigmoidf_(x); }
DEV float wave_sum(float v) { v += __shfl_xor(v, 1); v += __shfl_xor(v, 2); v += __shfl_xor(v, 4); v += __shfl_xor(v, 8); v += __shfl_xor(v, 16); v += __shfl_xor(v, 32); return v; }
DEV float wave_max(float v) { v = fmaxf(v, __shfl_xor(v, 1)); v = fmaxf(v, __shfl_xor(v, 2)); v = fmaxf(v, __shfl_xor(v, 4)); v = fmaxf(v, __shfl_xor(v, 8)); v = fmaxf(v, __shfl_xor(v, 16)); v = fmaxf(v, __shfl_xor(v, 32)); return v; }

DEV f32x16 mfma32(bf16x8 a, bf16x8 b, f32x16 c) {
#ifdef EMU
    struct { bf16x8 a, b; } mine{a, b};
    const unsigned char* base = emu_wave_exchange(&mine, 32);
    const int l = emu_lane(), col = l & 31, h = l >> 5;
    for (int r = 0; r < 16; ++r) {
        const int i = (r & 3) + 8 * (r >> 2) + 4 * h; float s = c[r];
        for (int hh = 0; hh < 2; ++hh) {
            bf16x8 av, bv; memcpy(&av, base + 256 * (i + 32 * hh), 16); memcpy(&bv, base + 256 * (col + 32 * hh) + 16, 16);
            for (int e = 0; e < 8; ++e) s += bf2f((bf16_t)av[e]) * bf2f((bf16_t)bv[e]);
        }
        c[r] = s;
    }
    return c;
#else
    return __builtin_amdgcn_mfma_f32_32x32x16_bf16(a, b, c, 0, 0, 0);
#endif
}
DEV f32x4 mfma16(bf16x8 a, bf16x8 b, f32x4 c) {
#ifdef EMU
    struct { bf16x8 a, b; } mine{a, b};
    const unsigned char* base = emu_wave_exchange(&mine, 32);
    const int l = emu_lane(), col = l & 15, q = l >> 4;
    for (int r = 0; r < 4; ++r) {
        const int i = 4 * q + r; float s = c[r];
        for (int kq = 0; kq < 4; ++kq) {
            bf16x8 av, bv; memcpy(&av, base + 256 * (i + 16 * kq), 16); memcpy(&bv, base + 256 * (col + 16 * kq) + 16, 16);
            for (int e = 0; e < 8; ++e) s += bf2f((bf16_t)av[e]) * bf2f((bf16_t)bv[e]);
        }
        c[r] = s;
    }
    return c;
#else
    return __builtin_amdgcn_mfma_f32_16x16x32_bf16(a, b, c, 0, 0, 0);
#endif
}
DEV void lds_inc(LDSQ unsigned* p) {
#ifdef EMU
    *p += 1u;
#else
    __hip_atomic_fetch_add(p, 1u, __ATOMIC_RELAXED, __HIP_MEMORY_SCOPE_WORKGROUP);
#endif
}
DEV u32x4 ldg16(const void* p) { return *(const u32x4*)p; }
#ifdef EMU
typedef const bf16_t* gbf_t;
#else
typedef const __attribute__((address_space(1))) bf16_t* gbf_t;
#endif
DEV u32x4 ldg16g(gbf_t p) {
#ifdef EMU
    return *(const u32x4*)p;
#else
    return *(const __attribute__((address_space(1))) u32x4*)p;
#endif
}
DEV u32x4 lds_ld16(lds_t p) { return *(LDSQ const u32x4*)p; }
DEV void lds_st16(lds_t p, u32x4 v) { *(LDSQ u32x4*)p = v; }
DEV bf16x8 as_bf8(u32x4 v) { bf16x8 r; __builtin_memcpy(&r, &v, 16); return r; }

#ifndef EMU
#define XB_TMO      128
#define XB_XCNT(j)  (256  + 64 * (j))
#define XB_XSUB(j)  (1280 + 64 * (j))
#define XB_XGEN(j)  (2304 + 64 * (j))
#define XB_TOP      3328
#define XB_TOPGEN   3392
#define XCD_BAR_WORDS 3456
#define XB_SPIN_CAP (1u << 24)
#define LAS __attribute__((address_space(3)))
__device__ __forceinline__ unsigned xb_ld(unsigned* p)              { return __hip_atomic_load(p, __ATOMIC_RELAXED, __HIP_MEMORY_SCOPE_AGENT); }
__device__ __forceinline__ unsigned xb_add(unsigned* p, unsigned v) { return __hip_atomic_fetch_add(p, v, __ATOMIC_RELAXED, __HIP_MEMORY_SCOPE_AGENT); }
__device__ __forceinline__ unsigned xb_xcc_id() { return (unsigned)__builtin_amdgcn_s_getreg((3 << 11) | 20) & 0xFu; }
#define XB_SPIN(cond, bar) do { unsigned _sp = 0; while (cond) { __builtin_amdgcn_s_sleep(1); \
    if ((++_sp & 255u) == 0u) { if (xb_ld(&(bar)[XB_TMO])) break; if (_sp > XB_SPIN_CAP) { atomicAdd(&(bar)[XB_TMO], 1u); break; } } } } while (0)
struct XcdBarrier { unsigned* bar; unsigned x; volatile LAS unsigned* st; };
__device__ __forceinline__ XcdBarrier xcd_barrier_post(unsigned* bar, volatile LAS unsigned* st) {
    XcdBarrier b; b.bar = bar; b.x = xb_xcc_id(); b.st = st;
    if (threadIdx.x == 0) (void)xb_add(&bar[XB_XCNT(b.x)], 1u);
    return b;
}
__device__ __forceinline__ void xcd_barrier_complete(unsigned* bar, unsigned x, unsigned& nloc, unsigned& nx) {
    const unsigned G = gridDim.x * gridDim.y * gridDim.z;
    unsigned sum, cnt, mine, sp = 0u;
    for (;;) {
        sum = 0u; cnt = 0u; mine = 0u;
#pragma unroll
        for (unsigned j = 0; j < 16; ++j) { const unsigned c = xb_ld(&bar[XB_XCNT(j)]); sum += c; cnt += (c > 0u) ? 1u : 0u; mine = (j == x) ? c : mine; }
        if (sum == G) break;
        __builtin_amdgcn_s_sleep(1);
        if ((++sp & 255u) == 0u) { if (xb_ld(&bar[XB_TMO])) break; if (sp > XB_SPIN_CAP) { atomicAdd(&bar[XB_TMO], 1u); break; } }
    }
    nloc = mine > 0u ? mine : 1u; nx = cnt > 0u ? cnt : 1u;
}
__device__ __forceinline__ void xcd_barrier(const XcdBarrier& b) {
    asm volatile("s_waitcnt vmcnt(0)" ::: "memory");
    __syncthreads();
    if (threadIdx.x == 0) {
        unsigned* bar = b.bar;
        __builtin_amdgcn_s_waitcnt(0);
        unsigned nloc = b.st[0], nx = b.st[1];
        if (nloc == 0u) { xcd_barrier_complete(bar, b.x, nloc, nx); b.st[0] = nloc; b.st[1] = nx; }
        const unsigned old = xb_add(&bar[XB_XSUB(b.x)], 1u);
        const unsigned gen = old / nloc;
        if (old + 1u == (gen + 1u) * nloc) {
            __builtin_amdgcn_fence(__ATOMIC_RELEASE, "agent");
            asm volatile("s_waitcnt vmcnt(0)" ::: "memory");
            const unsigned og = xb_add(&bar[XB_TOP], 1u);
            const unsigned tg = og / nx;
            if (og + 1u == (tg + 1u) * nx) xb_add(&bar[XB_TOPGEN], 1u);
            else XB_SPIN(xb_ld(&bar[XB_TOPGEN]) == tg, bar);
            __builtin_amdgcn_fence(__ATOMIC_ACQUIRE, "agent");
            xb_add(&bar[XB_XGEN(b.x)], 1u);
            asm volatile("s_waitcnt vmcnt(0)" ::: "memory");
        } else {
            XB_SPIN(xb_ld(&bar[XB_XGEN(b.x)]) == gen, bar);
            __builtin_amdgcn_fence(__ATOMIC_ACQUIRE, "agent");
            asm volatile("s_waitcnt vmcnt(0)" ::: "memory");
        }
    }
    __syncthreads();
}
#endif

template <int MT_, int NT_, int WM_, int WN_> struct GT {
    static constexpr int MT = MT_, NT = NT_, WM = WM_, WN = WN_;
    static constexpr int BM = 32 * MT * WM, BN = 32 * NT * WN, MI = 2 * MT, NI = 2 * NT;
    static constexpr int RS = 128, A_BYTES = BM * RS, B_BYTES = BN * RS, STAGE = A_BYTES + B_BYTES, LDS_BYTES = 2 * STAGE;
    static constexpr int ACH = BM / 64, BCH = BN / 64;
    static_assert(WM * WN == 8 && BM % 64 == 0 && BN % 64 == 0, "8 waves, loader rows");
};
typedef GT<2, 4, 4, 2> GBig;
typedef GT<1, 2, 2, 4> GSmall;
typedef GT<2, 2, 4, 2> GMid;

DEV void glds16(const void* g, lds_t wave_base) {
#ifdef EMU
    memcpy(wave_base + 16 * emu_lane(), g, 16);
#else
    __builtin_amdgcn_global_load_lds((const __attribute__((address_space(1))) unsigned*)g, (LDSQ unsigned*)wave_base, 16, 0, 0);
#endif
}
DEV int uniform_i(int v) {
#ifdef EMU
    return v;
#else
    return __builtin_amdgcn_readfirstlane(v);
#endif
}
#ifdef EMU
#define GEMM_SB()
#else
#define GEMM_SB() __builtin_amdgcn_sched_barrier(0)
#endif
template <class G, bool NULLS = false, int KMODE = 0, bool PIPE = true, class AFn>
DEV void gemm_acc(f32x4 (&acc)[G::MI][G::NI], AFn arow, const bf16_t* __restrict__ Bt, size_t ldb, int m0, int n0, int K, lds_t smem) {
    const int tid = TIDX, lane = tid & 63, wave = uniform_i(tid >> 6), wm = wave / G::WN, wn = wave % G::WN;
    const int lr = wave * 8 + (lane >> 3), lc = (lane & 7) ^ ((lr >> 1) & 7);
    const bf16_t* ap[G::ACH];
#pragma unroll
    for (int i = 0; i < G::ACH; ++i) ap[i] = arow(m0 + lr + 64 * i) + lc * 8;
    const bf16_t* bp = Bt + (size_t)(n0 + lr) * ldb + lc * 8;
    const int nk = K / 64;
    auto issue = [&](int kt, int st) {
        lds_t sa = smem + st * G::STAGE + wave * 1024, sb = sa + G::A_BYTES;
        const int ko = KMODE == 1 ? 0 : kt * 64;
#pragma unroll
        for (int i = 0; i < G::ACH; ++i) glds16(ap[i] + ko, sa + i * 8192);
#pragma unroll
        for (int i = 0; i < G::BCH; ++i) glds16(bp + (size_t)(64 * i) * ldb + ko, sb + i * 8192);
    };
    const int r16 = lane & 15, kq = lane >> 4;
    const int xr = (r16 >> 1) & 7, xt = (kq ^ (xr & 3)) * 16, xu = xr >> 2;
    const int aoff = (wm * 32 * G::MT + r16) * 128 + xt, boff = G::A_BYTES + (wn * 32 * G::NT + r16) * 128 + xt;
    constexpr int NH = G::NI / 2;
    issue(0, 0); __syncthreads();
    for (int kt = 0; kt < nk; ++kt) {
        if (kt + 1 < nk && KMODE != 3) issue(kt + 1, (kt + 1) & 1);
        lds_t st = smem + (kt & 1) * G::STAGE;
        if constexpr (!PIPE) {
#pragma unroll
            for (int kh = 0; kh < 2; ++kh) {
                const int ko = (kh ^ xu) * 64;
                bf16x8 a1[G::MI], b1[G::NI];
#pragma unroll
                for (int mi = 0; mi < G::MI; ++mi) a1[mi] = as_bf8(lds_ld16(st + aoff + ko + mi * 2048));
#pragma unroll
                for (int ni = 0; ni < G::NI; ++ni) b1[ni] = as_bf8(lds_ld16(st + boff + ko + ni * 2048));
#pragma unroll
                for (int mi = 0; mi < G::MI; ++mi)
#pragma unroll
                    for (int ni = 0; ni < G::NI; ++ni) acc[mi][ni] = mfma16(b1[ni], a1[mi], acc[mi][ni]);
                GEMM_SB();
            }
        } else {
        bf16x8 af[2][G::MI], bfr[2][NH];
        {
            const int ko = (0 ^ xu) * 64;
#pragma unroll
            for (int mi = 0; mi < G::MI; ++mi) af[0][mi] = as_bf8(lds_ld16(st + aoff + ko + mi * 2048));
#pragma unroll
            for (int j = 0; j < NH; ++j) bfr[0][j] = as_bf8(lds_ld16(st + boff + ko + j * 2048));
        }
#pragma unroll
        for (int sg = 0; sg < 4; ++sg) {
            const int kh = sg >> 1, nh = sg & 1;
            if (sg < 3) {
                const int kh2 = (sg + 1) >> 1, nh2 = (sg + 1) & 1, ko = (kh2 ^ xu) * 64;
                if (nh2 == 0) {
#pragma unroll
                    for (int mi = 0; mi < G::MI; ++mi) af[kh2][mi] = as_bf8(lds_ld16(st + aoff + ko + mi * 2048));
                }
#pragma unroll
                for (int j = 0; j < NH; ++j) bfr[(sg + 1) & 1][j] = as_bf8(lds_ld16(st + boff + ko + (nh2 * NH + j) * 2048));
            }
            GEMM_SB();
#pragma unroll
            for (int mi = 0; mi < G::MI; ++mi)
#pragma unroll
                for (int j = 0; j < NH; ++j) acc[mi][nh * NH + j] = mfma16(bfr[sg & 1][j], af[kh][mi], acc[mi][nh * NH + j]);
            GEMM_SB();
        }
        }
        __syncthreads();
    }
}
template <class G> DEV void zero_acc(f32x4 (&acc)[G::MI][G::NI]) {
#pragma unroll
    for (int mi = 0; mi < G::MI; ++mi)
#pragma unroll
        for (int ni = 0; ni < G::NI; ++ni) acc[mi][ni] = (f32x4){0.f, 0.f, 0.f, 0.f};
}
template <class G, class TF, class ST>
DEV void epi_lds_bf16(const f32x4 (&acc)[G::MI][G::NI], int m0, int n0, lds_t smem, TF tf, ST st) {
    constexpr int RSE = G::BN * 2 + 16;
    const int tid = TIDX, lane = tid & 63, wave = tid >> 6, wm = wave / G::WN, wn = wave % G::WN;
#pragma unroll
    for (int mi = 0; mi < G::MI; ++mi) {
        const int rl = wm * 32 * G::MT + mi * 16 + (lane & 15);
#pragma unroll
        for (int ni = 0; ni < G::NI; ++ni) {
            const int cl = wn * 32 * G::NT + ni * 16 + 4 * (lane >> 4);
            const f32x4 v = tf(m0 + rl, n0 + cl, acc[mi][ni]);
            u32x2 w; w.x = pack2(v[0], v[1]); w.y = pack2(v[2], v[3]);
            *(LDSQ u32x2*)(smem + rl * RSE + cl * 2) = w;
        }
    }
    __syncthreads();
    constexpr int CPR = G::BN / 8;
#pragma unroll 4
    for (int id = tid; id < G::BM * CPR; id += NTHR) { const int rl = id / CPR, cc = id % CPR; st(m0 + rl, n0 + cc * 8, lds_ld16(smem + rl * RSE + cc * 16)); }
    __syncthreads();
}
template <class G, class RM>
DEV void epi_lds_f32(const f32x4 (&acc)[G::MI][G::NI], int m0, int n0, lds_t smem, RM rm) {
    constexpr int RSF = G::BN * 4 + 16;
    static_assert(G::BM * RSF <= 160 * 1024 - 64, "f32 staging tile too large");
    const int tid = TIDX, lane = tid & 63, wave = tid >> 6, wm = wave / G::WN, wn = wave % G::WN;
#pragma unroll
    for (int mi = 0; mi < G::MI; ++mi)
#pragma unroll
        for (int ni = 0; ni < G::NI; ++ni)
            *(LDSQ f32x4*)(smem + (wm * 32 * G::MT + mi * 16 + (lane & 15)) * RSF + (wn * 32 * G::NT + ni * 16 + 4 * (lane >> 4)) * 4) = acc[mi][ni];
    __syncthreads();
    constexpr int CPR = G::BN / 8;
#pragma unroll 2
    for (int id = tid; id < G::BM * CPR; id += NTHR) {
        const int rl = id / CPR, cc = id % CPR;
        rm(m0 + rl, n0 + cc * 8, *(LDSQ const f32x4*)(smem + rl * RSF + cc * 32), *(LDSQ const f32x4*)(smem + rl * RSF + cc * 32 + 16));
    }
    __syncthreads();
}
DEV void unpack8f(u32x4 raw, f32x4& a, f32x4& b) {
    a = (f32x4){__uint_as_float(raw.x << 16), __uint_as_float(raw.x & 0xffff0000u), __uint_as_float(raw.y << 16), __uint_as_float(raw.y & 0xffff0000u)};
    b = (f32x4){__uint_as_float(raw.z << 16), __uint_as_float(raw.z & 0xffff0000u), __uint_as_float(raw.w << 16), __uint_as_float(raw.w & 0xffff0000u)};
}
DEV u32x4 pack8f(f32x4 a, f32x4 b) { u32x4 w; w.x = pack2(a[0], a[1]); w.y = pack2(a[2], a[3]); w.z = pack2(b[0], b[1]); w.w = pack2(b[2], b[3]); return w; }
DEV void st_bf4(bf16_t* p, f32x4 v) { u32x2 w; w.x = pack2(v[0], v[1]); w.y = pack2(v[2], v[3]); *(u32x2*)p = w; }

#ifdef EMU
#define KAS
#else
#define KAS __attribute__((address_space(4)))
#endif
struct Ctx { const KAS Params& p; lds_t smem; int bid, nblk, par; };
DEV int row_cond(int row) { return row < RL ? row / T : 2; }
DEV void row_bpos(int row, int& b, int& pos) { if (row < RL) { b = row / T; pos = TC + row % T; } else { const int rc = row - RL; b = rc / TC; pos = rc % TC; } }
DEV int bpos_row(int b, int pos) { return pos < TC ? RL + b * TC + pos : b * T + (pos - TC); }

constexpr int NCHC = TC / S5L, NCHL = T / S5L, NRL5 = NB * NCHL;
DEV int s5_cr(int b, int j) { return j >= NCHC ? b * NCHL + (j - NCHC) : NRL5 + b * NCHC + j; }
DEV void s5_cr_inv(int row, int& b, int& pos0) { if (row < NRL5) { b = row / NCHL; pos0 = TC + (row % NCHL) * 64; } else { const int r = row - NRL5; b = r / NCHC; pos0 = (r % NCHC) * 64; } }
DEV int perm_slot(int round, int bid, int nblk) { return (nblk & 7) == 0 ? round * nblk + (bid & 7) * (nblk >> 3) + (bid >> 3) : round * nblk + bid; }
DEV void grouped_tile(int w, int NMT, int NNT, int& mt, int& nt) {
    const int nig = 8 * NNT, grp = w / nig, fm = grp * 8, gsz = (NMT - fm) < 8 ? (NMT - fm) : 8, r = w % nig;
    mt = fm + r % gsz; nt = r / gsz;
}
DEV bool tile_order(int round, int bid, int nblk, int NMT, int NNT, int& mt, int& nt) {
    const int slot = perm_slot(round, bid, nblk);
    if (slot >= NMT * NNT) return false;
    grouped_tile(slot, NMT, NNT, mt, nt); return true;
}
DEV void phase_prologue(const Ctx& c) {
    const int tid = TIDX;
    float* modv = (float*)(c.p.ws + WS::MODV);
    {
        LDSQ float* red = (LDSQ float*)c.smem;
        const int nitem = NL * (6 * D / 64);
        for (int it = c.bid; it < nitem; it += c.nblk) {
            const int l = it / (6 * D / 64), j = (it % (6 * D / 64)) * 64 + (tid & 63), ksl = tid >> 6;
            const float* w = c.p.in[I_WMOD] + (size_t)l * D * 6 * D + j;
            float a0 = 0.f, a1 = 0.f, a2 = 0.f;
            for (int k = ksl * (D / 8); k < (ksl + 1) * (D / 8); ++k) {
                const float wv = w[(size_t)k * 6 * D];
                a0 += siluf_(c.p.in[I_C][k]) * wv; a1 += siluf_(c.p.in[I_C][D + k]) * wv; a2 += siluf_(c.p.in[I_CCTX][k]) * wv;
            }
            red[(ksl * 3 + 0) * 64 + (tid & 63)] = a0; red[(ksl * 3 + 1) * 64 + (tid & 63)] = a1; red[(ksl * 3 + 2) * 64 + (tid & 63)] = a2;
            __syncthreads();
            if (tid < 192) {
                const int cond = tid >> 6, jj = tid & 63; float s = 0.f;
                for (int q = 0; q < 8; ++q) s += red[(q * 3 + cond) * 64 + jj];
                const int jc = (it % (6 * D / 64)) * 64 + jj;
                modv[((size_t)l * 3 + cond) * 6 * D + jc] = s + c.p.in[I_BMOD][(size_t)l * 6 * D + jc];
            }
            __syncthreads();
        }
    }
    {
        float* xc = (float*)(c.p.ws + WS::XCUR);
        const size_t n4 = (size_t)R * D / 4, nl4 = (size_t)RL * D / 4;
        for (size_t i = (size_t)c.bid * NTHR + tid; i < n4; i += (size_t)c.nblk * NTHR) {
            f32x4 v = i < nl4 ? ((const f32x4*)c.p.in[I_X])[i] : ((const f32x4*)c.p.in[I_CTX])[i - nl4];
            ((f32x4*)xc)[i] = v;
        }
    }
    {
        float* rt = (float*)(c.p.ws + WS::ROPE);
        const int n = (T / 64 + 64) * 16;
        for (int i = c.bid * NTHR + tid; i < n; i += c.nblk * NTHR) {
            const int pos = i / 16, j = i % 16;
            const float invf = powf(10000.0f, -(float)j / 16.0f);
            const float idx = pos < T / 64 ? (float)pos : (float)(pos - T / 64);
            const float ang = idx * invf;
            rt[2 * i] = cosf(ang); rt[2 * i + 1] = sinf(ang);
        }
    }
}

template <class MapFn>
DEV void convert_tile(const Ctx& c, MapFn colptr, size_t ld, int K, bf16_t* __restrict__ dst, int it, int nkt) {
    LDSQ unsigned* tile = (LDSQ unsigned*)c.smem;
    const int tid = TIDX, lane = tid & 63, wave = tid >> 6;
    const int k0 = (it % nkt) * 64, n0 = (it / nkt) * 256;
    const float* src = colptr(n0 + 4 * lane);
    f32x4 v[8];
#pragma unroll
    for (int j = 0; j < 8; ++j) v[j] = src ? *(const f32x4*)(src + (size_t)(k0 + wave * 8 + j) * ld) : (f32x4){0.f, 0.f, 0.f, 0.f};
#pragma unroll
    for (int j = 0; j < 4; ++j)
#pragma unroll
        for (int i = 0; i < 4; ++i) tile[(4 * lane + i) * 33 + wave * 4 + j] = pack2(v[2 * j][i], v[2 * j + 1][i]);
    __syncthreads();
#pragma unroll
    for (int i = 0; i < 4; ++i) {
        const int id = tid + NTHR * i, n = id >> 3, ch = id & 7;
        u32x4 w; w.x = tile[n * 33 + 4 * ch]; w.y = tile[n * 33 + 4 * ch + 1]; w.z = tile[n * 33 + 4 * ch + 2]; w.w = tile[n * 33 + 4 * ch + 3];
        *(u32x4*)(dst + (size_t)(n0 + n) * K + k0 + ch * 8) = w;
    }
    __syncthreads();
}
struct ColMap {
    int mode; const float* a; const float* b;
    DEV const float* operator()(int n) const {
        if (mode == 0) return a + n;
        if (mode == 1) { if (n < 4096) return a + n; if (n < LDP) return a + n + 16; if (n < LDP + 16) return a + 4096 + (n - LDP); return nullptr; }
        const int hb = n >> 5, w = n & 31; return (w < 16 ? a : b) + 16 * hb + (w & 15);
    }
};
DEV void phase_convert(const Ctx& c, int l) {
    unsigned char* ws = c.p.ws;
    const size_t wso = (size_t)(l & 1) * WS::WSET;
    constexpr int T_IN = (D / 64) * (NPIN / 256), T_GLU = (512 / 64) * (512 / 256), T_BR = (512 / 64) * (D / 256), T_OUT = (D / 64) * (D / 256);
    constexpr int T_GU = (D / 64) * (2 * DE / 256), T_DN = (DE / 64) * (D / 256), T_EX = T_GU + T_DN;
    constexpr int O_GLU = T_IN, O_BR = O_GLU + T_GLU, O_OUT = O_BR + 3 * T_BR, O_EX = O_OUT + T_OUT, T_ALL = O_EX + NE * T_EX;
    for (int t = c.bid; t < T_ALL; t += c.nblk) {
        if (t < O_GLU) convert_tile(c, ColMap{1, c.p.in[I_WIN] + (size_t)l * D * DIN, nullptr}, DIN, D, (bf16_t*)(ws + WS::WIN + wso), t, D / 64);
        else if (t < O_BR) convert_tile(c, ColMap{0, c.p.in[I_S5GLU] + (size_t)l * 512 * 512, nullptr}, 512, 512, (bf16_t*)(ws + WS::WGLU + wso), t - O_GLU, 512 / 64);
        else if (t < O_OUT) { const int j = (t - O_BR) / T_BR, it = (t - O_BR) % T_BR; convert_tile(c, ColMap{0, c.p.in[I_WBR] + ((size_t)l * 3 + j) * 512 * D, nullptr}, D, 512, (bf16_t*)(ws + WS::WBR + wso) + (size_t)j * D * 512, it, 512 / 64); }
        else if (t < O_EX) convert_tile(c, ColMap{0, c.p.in[I_WOUT] + (size_t)l * D * D, nullptr}, D, D, (bf16_t*)(ws + WS::WOUT + wso), t - O_OUT, D / 64);
        else {
            const int u = t - O_EX, e = u / T_EX, r = u % T_EX;
            if (r < T_GU) convert_tile(c, ColMap{2, c.p.in[I_WEG] + ((size_t)l * NE + e) * D * DE, c.p.in[I_WEU] + ((size_t)l * NE + e) * D * DE}, DE, D, (bf16_t*)(ws + WS::WGU + wso) + (size_t)e * 2 * DE * D, r, D / 64);
            else convert_tile(c, ColMap{0, c.p.in[I_WED] + ((size_t)l * NE + e) * DE * D, nullptr}, D, DE, (bf16_t*)(ws + WS::WDN + wso) + (size_t)e * D * DE, r - T_GU, DE / 64);
        }
    }
}

DEV void phase_norm(const Ctx& c, int l, int which) {
    const int lane = TIDX & 63, wave = TIDX >> 6;
    const float* xc = (const float*)(c.p.ws + WS::XCUR);
    bf16_t* dst = (bf16_t*)(c.p.ws + WS::A1);
    const float* modv = (const float*)(c.p.ws + WS::MODV) + (size_t)l * 3 * 6 * D;
    constexpr int NV = D / 256;
    for (int row = c.bid * 8 + wave; row < R; row += c.nblk * 8) {
        const float* xr = xc + (size_t)row * D;
        f32x4 v[NV]; float ss = 0.f;
#pragma unroll
        for (int i = 0; i < NV; ++i) { v[i] = *(const f32x4*)(xr + i * 256 + lane * 4); ss += v[i][0] * v[i][0] + v[i][1] * v[i][1] + v[i][2] * v[i][2] + v[i][3] * v[i][3]; }
        ss = wave_sum(ss);
        const float inv = 1.0f / sqrtf(ss * (1.0f / D) + EPS);
        const float* mv = modv + (size_t)row_cond(row) * 6 * D + which * 3 * D;
#pragma unroll
        for (int i = 0; i < NV; ++i) {
            const int col = i * 256 + lane * 4;
            const f32x4 sh = *(const f32x4*)(mv + col), sc = *(const f32x4*)(mv + D + col);
            const f32x4 o = v[i] * inv * (sc + 1.0f) + sh;
            st_bf4(dst + (size_t)row * D + col, o);
        }
    }
}

DEV void phase_inproj(const Ctx& c) {
    const bf16_t* A = (const bf16_t*)(c.p.ws + WS::A1); const bf16_t* Bt = (const bf16_t*)(c.p.ws + WS::WIN + (size_t)c.par * WS::WSET);
    bf16_t* P = (bf16_t*)(c.p.ws + WS::PBUF); float* gates = (float*)(c.p.ws + WS::GATES);
    constexpr int NMT = R / 256, NNT = NPIN / 256;
    for (int rnd = 0;; ++rnd) {
        int mt, nt; if (!tile_order(rnd, c.bid, c.nblk, NMT, NNT, mt, nt)) break;
        const int m0 = mt * 256, n0 = nt * 256;
        f32x4 acc[GBig::MI][GBig::NI]; zero_acc<GBig>(acc);
        gemm_acc<GBig>(acc, [=](int m) { return A + (size_t)m * D; }, Bt, D, m0, n0, D, c.smem);
        epi_lds_bf16<GBig>(acc, m0, n0, c.smem,
            [=](int row, int col, f32x4 v) { if (col >= LDP && col < LDP + 16) *(f32x4*)(gates + (size_t)row * 16 + (col - LDP)) = v; return v; },
            [=](int row, int col, u32x4 w) { if (col < LDP) *(u32x4*)(P + (size_t)row * LDP + col) = w; });
    }
}

template <int KMODE> DEV void probe_inproj(const Ctx& c) {
    const bf16_t* A = (const bf16_t*)(c.p.ws + WS::A1); const bf16_t* Bt = (const bf16_t*)(c.p.ws + WS::WIN + (size_t)c.par * WS::WSET);
    float* gates = (float*)(c.p.ws + WS::GATES);
    constexpr int NMT = R / 256, NNT = NPIN / 256;
    for (int rnd = 0;; ++rnd) {
        int mt, nt; if (!tile_order(rnd, c.bid, c.nblk, NMT, NNT, mt, nt)) break;
        f32x4 acc[GBig::MI][GBig::NI]; zero_acc<GBig>(acc);
        gemm_acc<GBig, false, KMODE>(acc, [=](int m) { return A + (size_t)m * D; }, Bt, D, mt * 256, nt * 256, D, c.smem);
        float sgn = 0.f;
#pragma unroll
        for (int i = 0; i < GBig::MI; ++i)
#pragma unroll
            for (int j = 0; j < GBig::NI; ++j)
#pragma unroll
                for (int r = 0; r < 4; ++r) sgn += acc[i][j][r];
        if (sgn == 123456.789f) gates[0] = sgn;
    }
}
constexpr int PT_STRIDE = 1040;
DEV void tile_transpose_out(lds_t tile, bf16_t* dst, int b, int pos0, bool perm) {
    const int tid = TIDX;
#pragma unroll 1
    for (int i = 0; i < 8; ++i) {
        const int chunk = tid + NTHR * i, ch = chunk >> 3, pc = chunk & 7;
        unsigned short e[8];
#pragma unroll
        for (int j = 0; j < 8; ++j) {
            const int o = perm ? (32 * (pc >> 2) + 16 * (j >> 2) + 4 * (pc & 3) + (j & 3)) : (8 * pc + j);
            e[j] = *(LDSQ const unsigned short*)(tile + o * PT_STRIDE + ch * 2);
        }
        u32x4 w; w.x = e[0] | ((unsigned)e[1] << 16); w.y = e[2] | ((unsigned)e[3] << 16); w.z = e[4] | ((unsigned)e[5] << 16); w.w = e[6] | ((unsigned)e[7] << 16);
        *(u32x4*)(dst + ((size_t)b * 512 + ch) * TK + pos0 + pc * 8) = w;
    }
}
DEV void tile_load(lds_t tile, const bf16_t* P, int row_first, int nrows, int col0, int valid_lo, int valid_hi) {
    const int tid = TIDX;
    for (int chunk = tid; chunk < nrows * 64; chunk += NTHR) {
        const int r = chunk >> 6, cc = chunk & 63, row = row_first + r;
        u32x4 v = (u32x4){0u, 0u, 0u, 0u};
        if (row >= valid_lo && row < valid_hi) v = ldg16(P + (size_t)row * LDP + col0 + cc * 8);
        lds_st16(tile + r * PT_STRIDE + cc * 16, v);
    }
}
DEV void phase_prep(const Ctx& c, int l) {
    unsigned char* ws = c.p.ws;
    const bf16_t* P = (const bf16_t*)(ws + WS::PBUF);
    const int tid = TIDX, lane = tid & 63, wave = tid >> 6;
    const int nitem = NCH * 6;
    for (int it = c.bid; it < nitem; it += c.nblk) {
        const int sub = it % 6, tl = it / 6;
        const int b = tl / NCHB, pos0 = (tl % NCHB) * 64;
        const int row0 = bpos_row(b, pos0);
        const bool latent = pos0 >= TC;
        if (sub == 0) {
            const float* rt = (const float*)(ws + WS::ROPE);
            for (int task = wave; task < 128; task += 8) {
                const int s = task >> 1, which = task & 1, row = row0 + s, pos = pos0 + s;
                const u32x4 raw = ldg16(P + (size_t)row * LDP + which * 512 + lane * 8);
                float x[8];
#pragma unroll
                for (int e = 0; e < 4; ++e) { x[2 * e] = __uint_as_float(raw[e] << 16); x[2 * e + 1] = __uint_as_float(raw[e] & 0xffff0000u); }
                float ss = 0.f;
#pragma unroll
                for (int e = 0; e < 8; ++e) ss += x[e] * x[e];
                ss += __shfl_xor(ss, 1); ss += __shfl_xor(ss, 2); ss += __shfl_xor(ss, 4);
                const float inv = 1.0f / sqrtf(ss * (1.0f / 64.0f) + EPS);
                const float* gain = (which ? c.p.in[I_KG] : c.p.in[I_QG]) + (size_t)l * 64 + (lane & 7) * 8;
                float y[8], o[8];
#pragma unroll
                for (int e = 0; e < 8; ++e) y[e] = x[e] * inv * gain[e];
                if (latent) {
                    const int t = pos - TC, hi = (lane >> 2) & 1;
#pragma unroll
                    for (int e = 0; e < 8; ++e) {
                        const float other = __shfl_xor(y[e], 4);
                        const int jj = (lane & 3) * 8 + e;
                        const float* cs = jj < 16 ? rt + ((size_t)(t / 64) * 16 + jj) * 2 : rt + ((size_t)(T / 64 + (t % 64)) * 16 + (jj - 16)) * 2;
                        o[e] = hi ? (y[e] * cs[0] + other * cs[1]) : (y[e] * cs[0] - other * cs[1]);
                    }
                } else {
#pragma unroll
                    for (int e = 0; e < 8; ++e) o[e] = y[e];
                }
                const float scl = which ? 1.0f : 0.18033688011112042f;
                u32x4 w; w.x = pack2(o[0] * scl, o[1] * scl); w.y = pack2(o[2] * scl, o[3] * scl); w.z = pack2(o[4] * scl, o[5] * scl); w.w = pack2(o[6] * scl, o[7] * scl);
                const int grp = lane >> 3, head = grp >> 1, map = grp & 1;
                bf16_t* dst = (bf16_t*)(ws + (which ? WS::KP : WS::QP)) + (((size_t)b * 4 + head) * TK + pos) * 128 + map * 64 + (lane & 7) * 8;
                *(u32x4*)dst = w;
            }
        } else if (sub == 1) {
            tile_load(c.smem, P, row0, 64, 1024, 0, R); __syncthreads();
            tile_transpose_out(c.smem, (bf16_t*)(ws + WS::VT), b, pos0, true); __syncthreads();
        } else if (sub == 2) {
            tile_load(c.smem, P, row0, 64, 1536, 0, R); __syncthreads();
            bf16_t* ug = (bf16_t*)(ws + WS::UG);
#pragma unroll 1
            for (int i = 0; i < 8; ++i) {
                const int chunk = tid + NTHR * i, g = chunk >> 7, s = (chunk >> 1) & 63, half = chunk & 1;
                const u32x4 v = lds_ld16(c.smem + s * PT_STRIDE + g * 32 + half * 16);
                *(u32x4*)(ug + ((size_t)g * NCH + s5_cr(b, tl % NCHB)) * 1280 + s * 16 + half * 8) = v;
            }
            __syncthreads();
        } else if (sub == 3 || sub == 4) {
            const int isk = sub == 4;
            const int seg_lo = latent ? bpos_row(b, TC) : bpos_row(b, 0), seg_hi = seg_lo + (latent ? T : TC);
            tile_load(c.smem, P, row0 - 2, 68, isk ? 2560 : 2048, seg_lo, seg_hi); __syncthreads();
            lds_t otile = c.smem + 68 * PT_STRIDE;
            const float* cw = c.p.in[I_CONVW] + (size_t)l * 5 * 1024 + isk * 512; const float* cb = c.p.in[I_CONVB] + (size_t)l * 1024 + isk * 512;
            bf16_t* dst = (bf16_t*)(ws + (isk ? WS::MK : WS::MQ));
#pragma unroll 1
            for (int i = 0; i < 8; ++i) {
                const int chunk = tid + NTHR * i, s = chunk >> 6, cc = chunk & 63;
                float a[8];
#pragma unroll
                for (int e = 0; e < 8; ++e) a[e] = cb[cc * 8 + e];
#pragma unroll
                for (int j = 0; j < 5; ++j) {
                    const u32x4 raw = lds_ld16(c.smem + (s + j) * PT_STRIDE + cc * 16);
#pragma unroll
                    for (int e = 0; e < 4; ++e) { a[2 * e] += __uint_as_float(raw[e] << 16) * cw[j * 1024 + cc * 8 + 2 * e]; a[2 * e + 1] += __uint_as_float(raw[e] & 0xffff0000u) * cw[j * 1024 + cc * 8 + 2 * e + 1]; }
                }
                const float scl = isk ? 0.08838834764831845f : 1.0f;
#pragma unroll
                for (int e = 0; e < 8; ++e) a[e] = siluf_(a[e]) * scl;
                u32x4 w; w.x = pack2(a[0], a[1]); w.y = pack2(a[2], a[3]); w.z = pack2(a[4], a[5]); w.w = pack2(a[6], a[7]);
                const int ch = cc * 8, head = ch >> 7, d = ch & 127;
                *(u32x4*)(dst + (((size_t)b * 4 + head) * TK + pos0 + s) * 128 + d) = w;
                if (isk) lds_st16(otile + s * PT_STRIDE + cc * 16, w);
            }
            __syncthreads();
            if (isk) { tile_transpose_out(otile, (bf16_t*)(ws + WS::MKT), b, pos0, false); __syncthreads(); }
        } else {
            tile_load(c.smem, P, row0, 64, 3072, 0, R); __syncthreads();
            tile_transpose_out(c.smem, (bf16_t*)(ws + WS::MVT), b, pos0, false);
            const float* gates = (const float*)(ws + WS::GATES);
            float* ig = (float*)(ws + WS::MIG); float* lf = (float*)(ws + WS::MLF);
            {
                const int s = tid >> 3, dir = (tid >> 2) & 1, head = tid & 3, row = row0 + s;
                const float gi = gates[(size_t)row * 16 + dir * 8 + head] + c.p.in[I_IB][(size_t)l * 8 + dir * 4 + head];
                const float gf = gates[(size_t)row * 16 + dir * 8 + 4 + head] + c.p.in[I_FB][(size_t)l * 8 + dir * 4 + head];
                const size_t o = (((size_t)dir * NB + b) * 4 + head) * TK + pos0 + s;
                ig[o] = gi;
                lf[o] = fminf(gf, 0.f) - log1pf(fexp(-fabsf(gf)));
            }
            __syncthreads();
        }
    }
}

constexpr int ATT_KB = 128 * 256, ATT_STAGE = ATT_KB + 128 * 256;
DEV void attn_item(const Ctx& c, int l, int b, int head, int qpos0, int nkeys) {
    unsigned char* ws = c.p.ws;
    const int tid = TIDX, lane = tid & 63, wave = tid >> 6, fr = lane & 31, fh = lane >> 5, map = wave >> 2, qg = wave & 3;
    const bf16_t* Q = (const bf16_t*)(ws + WS::QP) + ((size_t)b * 4 + head) * TK * 128;
    const bf16_t* Kp = (const bf16_t*)(ws + WS::KP) + ((size_t)b * 4 + head) * TK * 128;
    const bf16_t* Vt = (const bf16_t*)(ws + WS::VT) + ((size_t)b * 4 + head) * 128 * TK;
    float gqm = 0.f, gkm = 0.f, d01 = 0.f, d23 = 0.f;
    for (int i = 0; i < 64; ++i) {
        gqm = fmaxf(gqm, fabsf(c.p.in[I_QG][l * 64 + i])); gkm = fmaxf(gkm, fabsf(c.p.in[I_KG][l * 64 + i]));
        const float* lv = c.p.in[I_LAMV] + (size_t)l * 256;
        d01 += lv[i] * lv[64 + i]; d23 += lv[128 + i] * lv[192 + i];
    }
    const float lam_init = 0.8f - 0.6f * expf(-0.3f * (float)l);
    const float lam = expf(d01) - expf(d23) + lam_init;
    const float shift = fmaxf(0.0f, 8.0f * gqm * gkm * 1.44269504089f * 1.02f - 64.0f);
    const int r16 = lane & 15, kq = lane >> 4;
    bf16x8 qf[2][2];
#pragma unroll
    for (int qt = 0; qt < 2; ++qt) {
        const bf16_t* qr = Q + (size_t)(qpos0 + qg * 32 + qt * 16 + r16) * 128 + map * 64 + kq * 8;
        qf[qt][0] = as_bf8(ldg16(qr)); qf[qt][1] = as_bf8(ldg16(qr + 32));
    }
    f32x4 O[8][2];
#pragma unroll
    for (int t = 0; t < 8; ++t) { O[t][0] = (f32x4){0.f, 0.f, 0.f, 0.f}; O[t][1] = O[t][0]; }
    const int wv = uniform_i(wave);
    const int pr0 = tid >> 4;
    const int plc = ((lane & 15) ^ (pr0 & 15)) << 3;
    gbf_t pk0 = (gbf_t)(Kp + (size_t)pr0 * 128 + plc);
    gbf_t pv0 = (gbf_t)(Vt + (size_t)pr0 * TK + plc);
#ifndef EMU
    asm volatile("" : "+v"(pv0));
#define ATT_SB() __builtin_amdgcn_sched_barrier(0)
#else
#define ATT_SB()
#endif
    auto issue = [&](int st) {
        lds_t base = c.smem + st * ATT_STAGE + wv * 1024;
#pragma unroll
        for (int i = 0; i < 4; ++i) { glds16((const void*)(pk0 + (size_t)i * 32 * 128), base + i * 8192); glds16((const void*)(pv0 + (size_t)i * 32 * TK), base + ATT_KB + i * 8192); }
    };
    auto advance = [&]() { pk0 += 128 * 128; pv0 += 128; };
    const int xk = r16;
    int koff[2], voff[4];
#pragma unroll
    for (int kh = 0; kh < 2; ++kh) koff[kh] = r16 * 256 + ((((map ^ (xk >> 3)) << 3) + ((kh ^ ((xk >> 2) & 1)) << 2) + (kq ^ (xk & 3))) << 4);
#pragma unroll
    for (int sub = 0; sub < 4; ++sub) voff[sub] = ATT_KB + r16 * 256 + ((((sub ^ (xk >> 2)) << 2) + (kq ^ (xk & 3))) << 4);
    const int nkt = nkeys / 128;
    issue(0); __syncthreads(); advance();
    f32x4 ls[2] = {(f32x4){0.f, 0.f, 0.f, 0.f}, (f32x4){0.f, 0.f, 0.f, 0.f}};
#pragma unroll 1
    for (int kt = 0; kt < nkt; ++kt) {
        if (kt + 1 < nkt) issue((kt + 1) & 1);
        lds_t sb = c.smem + (kt & 1) * ATT_STAGE;
#pragma unroll
        for (int hp = 0; hp < 2; ++hp) {
            bf16x8 kf[2][2], vf[8], pf[2];
            f32x4 S0[2][2], S1[2][2];
#pragma unroll
            for (int k2 = 0; k2 < 2; ++k2)
#pragma unroll
                for (int kh = 0; kh < 2; ++kh) kf[k2][kh] = as_bf8(lds_ld16(sb + koff[kh] + hp * 16384 + k2 * 4096));
#pragma unroll
            for (int k2 = 0; k2 < 2; ++k2)
#pragma unroll
                for (int qt = 0; qt < 2; ++qt) { S0[k2][qt] = (f32x4){0.f, 0.f, 0.f, 0.f}; S1[k2][qt] = S0[k2][qt]; }
#pragma unroll
            for (int kh = 0; kh < 2; ++kh)
#pragma unroll
                for (int k2 = 0; k2 < 2; ++k2)
#pragma unroll
                    for (int qt = 0; qt < 2; ++qt) S0[k2][qt] = mfma16(kf[k2][kh], qf[qt][kh], S0[k2][qt]);
#pragma unroll
            for (int dvt = 0; dvt < 8; ++dvt) vf[dvt] = as_bf8(lds_ld16(sb + voff[2 * hp] + dvt * 4096));
#pragma unroll
            for (int k2 = 0; k2 < 2; ++k2)
#pragma unroll
                for (int kh = 0; kh < 2; ++kh) kf[k2][kh] = as_bf8(lds_ld16(sb + koff[kh] + hp * 16384 + 8192 + k2 * 4096));
            ATT_SB();
#pragma unroll
            for (int kh = 0; kh < 2; ++kh)
#pragma unroll
                for (int k2 = 0; k2 < 2; ++k2)
#pragma unroll
                    for (int qt = 0; qt < 2; ++qt) S1[k2][qt] = mfma16(kf[k2][kh], qf[qt][kh], S1[k2][qt]);
            if (shift != 0.f) {
#pragma unroll
                for (int k2 = 0; k2 < 2; ++k2)
#pragma unroll
                    for (int qt = 0; qt < 2; ++qt) { S0[k2][qt] -= shift; S1[k2][qt] -= shift; }
            }
#pragma unroll
            for (int qt = 0; qt < 2; ++qt) {
#pragma unroll
                for (int k2 = 0; k2 < 2; ++k2)
#pragma unroll
                    for (int r = 0; r < 4; ++r) S0[k2][qt][r] = fexp2(S0[k2][qt][r]);
                ls[qt] += S0[0][qt] + S0[1][qt];
                pf[qt] = as_bf8(pack8f(S0[0][qt], S0[1][qt]));
            }
            ATT_SB();
#pragma unroll
            for (int dvt = 0; dvt < 8; ++dvt) { O[dvt][0] = mfma16(vf[dvt], pf[0], O[dvt][0]); O[dvt][1] = mfma16(vf[dvt], pf[1], O[dvt][1]); }
#pragma unroll
            for (int dvt = 0; dvt < 8; ++dvt) vf[dvt] = as_bf8(lds_ld16(sb + voff[2 * hp + 1] + dvt * 4096));
#pragma unroll
            for (int qt = 0; qt < 2; ++qt) {
#pragma unroll
                for (int k2 = 0; k2 < 2; ++k2)
#pragma unroll
                    for (int r = 0; r < 4; ++r) S1[k2][qt][r] = fexp2(S1[k2][qt][r]);
                ls[qt] += S1[0][qt] + S1[1][qt];
                pf[qt] = as_bf8(pack8f(S1[0][qt], S1[1][qt]));
            }
            ATT_SB();
#pragma unroll
            for (int dvt = 0; dvt < 8; ++dvt) { O[dvt][0] = mfma16(vf[dvt], pf[0], O[dvt][0]); O[dvt][1] = mfma16(vf[dvt], pf[1], O[dvt][1]); }
        }
        __syncthreads();
        advance();
    }
    float lt[2];
#pragma unroll
    for (int qt = 0; qt < 2; ++qt) { float v = (ls[qt][0] + ls[qt][1]) + (ls[qt][2] + ls[qt][3]); v += __shfl_xor(v, 16); v += __shfl_xor(v, 32); lt[qt] = v; }
    LDSQ float* xch = (LDSQ float*)c.smem;
    if (map == 1) {
#pragma unroll
        for (int qt = 0; qt < 2; ++qt) {
            const float sc = lam / lt[qt];
#pragma unroll
            for (int t = 0; t < 8; ++t)
#pragma unroll
                for (int r = 0; r < 4; ++r) xch[(qg * 64 + (t * 2 + qt) * 4 + r) * 64 + lane] = O[t][qt][r] * sc;
        }
    }
    __syncthreads();
    if (map == 0) {
        const float* og = c.p.in[I_OG] + (size_t)l * 128;
#pragma unroll
        for (int qt = 0; qt < 2; ++qt) {
            const float i0 = 1.0f / lt[qt];
            float ss = 0.f;
#pragma unroll
            for (int t = 0; t < 8; ++t)
#pragma unroll
                for (int r = 0; r < 4; ++r) { const float o = O[t][qt][r] * i0 - xch[(qg * 64 + (t * 2 + qt) * 4 + r) * 64 + lane]; O[t][qt][r] = o; ss += o * o; }
            ss += __shfl_xor(ss, 16); ss += __shfl_xor(ss, 32);
            const float inv = (1.0f - lam_init) / sqrtf(ss * (1.0f / 128.0f) + EPS);
            const int row = bpos_row(b, qpos0 + qg * 32 + qt * 16 + r16);
            bf16_t* ya = (bf16_t*)(ws + WS::YA) + (size_t)row * 512 + head * 128;
#pragma unroll
            for (int t = 0; t < 8; ++t) {
                const int dv = 16 * t + 4 * kq;
                st_bf4(ya + dv, O[t][qt] * inv * *(const f32x4*)(og + dv));
            }
        }
    }
    __syncthreads();
}
constexpr int ATT_QB = T / 128, ATT_LAT = NB * 4 * ATT_QB, ATT_CTX = NB * 4 * (TC / 128);
DEV void s5_local_item(const Ctx& c, int it);
DEV void ml_local_item(const Ctx& c, int it);
DEV void phase_mix1(const Ctx& c, int l) {
    for (int rep = 0; rep < (PROBE_SUB == 1 ? 2 : 1); ++rep)
    for (int it = c.bid; it < NB * 4 * NCM; it += c.nblk) ml_local_item(c, it);
    for (int rep = 0; rep < (PROBE_SUB == 2 ? 2 : 1); ++rep)
    for (int it = c.bid; it < 32 * ((NCH + 63) / 64); it += c.nblk) s5_local_item(c, it);
    for (int rep = 0; rep < (PROBE_SUB == 3 ? 2 : 1); ++rep)
    for (int it = c.bid; it < ATT_LAT + ATT_CTX; it += c.nblk) {
        int bh, qpos0, nkeys;
        if (it < ATT_LAT) { bh = it / ATT_QB; qpos0 = TC + (it % ATT_QB) * 128; nkeys = TK; }
        else { const int j = it - ATT_LAT; bh = j / (TC / 128); qpos0 = (j % (TC / 128)) * 128; nkeys = TC; }
        attn_item(c, l, bh >> 2, bh & 3, qpos0, nkeys);
    }
}

struct S5Base { float mag_l, ang, fre, fim; };
DEV S5Base s5_base(const Ctx& c, int l, int dir, int g, int p) {
    const size_t i = (((size_t)l * 2 + dir) * 32 + g) * 64 + p;
    const float lre = c.p.in[I_S5LRE][i], lim = c.p.in[I_S5LIM][i], dt = expf(c.p.in[I_S5STEP][((size_t)l * 2 + dir) * 32 + g]);
    S5Base r; r.mag_l = lre * dt; r.ang = lim * dt;
    const float cs = cosf(r.ang), sn = sinf(r.ang), em1 = expm1f(r.mag_l);
    const float nr = em1 * cs + (cs - 1.0f), ni = (em1 + 1.0f) * sn, den = lre * lre + lim * lim;
    r.fre = (nr * lre + ni * lim) / den; r.fim = (ni * lre - nr * lim) / den;
    return r;
}
DEV void s5_pow(const S5Base& a, int n, float& re, float& im) { const float m = expf(a.mag_l * (float)n), an = a.ang * (float)n; re = m * cosf(an); im = m * sinf(an); }
DEV void phase_s5_tab1(const Ctx& c, int l) {
    const int tid = TIDX;
    LDSQ float* sm = (LDSQ float*)c.smem;
    LDSQ float* bbar = sm;
    LDSQ float* apow = sm + 2048;
    float* kt = (float*)(c.p.ws + WS::S5KT); float* a64 = (float*)(c.p.ws + WS::S5A64) + (size_t)(l & 1) * 2 * 32 * 64 * 2;
    for (int it = c.bid; it < 32 * 2 * 8; it += c.nblk) {
        const int lb = it & 7, dir = (it >> 3) & 1, g = it >> 4;
        {
            const int p = tid & 63, ll = tid >> 6;
            const S5Base a = s5_base(c, l, dir, g, p);
            float re, im; s5_pow(a, lb * 8 + ll, re, im); apow[(ll * 64 + p) * 2] = re; apow[(ll * 64 + p) * 2 + 1] = im;
            if (lb == 0 && ll == 0) { s5_pow(a, 64, re, im); a64[((dir * 32 + g) * 64 + p) * 2] = re; a64[((dir * 32 + g) * 64 + p) * 2 + 1] = im; }
            for (int h = ll; h < 16; h += 8) {
                const size_t bi = ((((size_t)l * 2 + dir) * 32 + g) * 64 + p) * 16 + h;
                const float br = c.p.in[I_S5BRE][bi], bim = c.p.in[I_S5BIM][bi];
                bbar[(p * 16 + h) * 2] = a.fre * br - a.fim * bim; bbar[(p * 16 + h) * 2 + 1] = a.fre * bim + a.fim * br;
            }
        }
        __syncthreads();
        {
            const int ll = tid >> 6, hp = (tid >> 2) & 15, hq = tid & 3;
            const size_t ci = ((((size_t)l * 2 + dir) * 32 + g) * 16 + hp) * 64;
            float acc[4] = {0.f, 0.f, 0.f, 0.f};
            for (int p = 0; p < 64; ++p) {
                const float cr = c.p.in[I_S5CRE][ci + p], cim = c.p.in[I_S5CIM][ci + p];
                const float ar = apow[(ll * 64 + p) * 2], ai = apow[(ll * 64 + p) * 2 + 1];
                const float gr = cr * ar - cim * ai, gi = cr * ai + cim * ar;
#pragma unroll
                for (int e = 0; e < 4; ++e) acc[e] += gr * bbar[(p * 16 + hq * 4 + e) * 2] - gi * bbar[(p * 16 + hq * 4 + e) * 2 + 1];
            }
            *(f32x4*)(kt + ((((size_t)g * 2 + dir) * 64 + lb * 8 + ll) * 256 + hp * 16 + hq * 4)) = (f32x4){acc[0], acc[1], acc[2], acc[3]};
        }
        __syncthreads();
    }
}
DEV void phase_s5_tab2(const Ctx& c, int l) {
    const int tid = TIDX;
    const float* kt = (const float*)(c.p.ws + WS::S5KT);
    bf16_t* toep = (bf16_t*)(c.p.ws + WS::S5TOEP); bf16_t* minm = (bf16_t*)(c.p.ws + WS::S5MIN);
    for (int it = c.bid; it < 32 * 64; it += c.nblk) {
        const int g = it >> 6, t = it & 63;
#pragma unroll 1
        for (int i = 0; i < 4; ++i) {
            const int chunk = tid + NTHR * i, hp = chunk >> 7, kc = chunk & 127, s = kc >> 1, h0 = (kc & 1) * 8;
            const float* kf = kt + ((((size_t)g * 2 + 0) * 64 + (s < t ? t - s : 0)) * 256 + hp * 16 + h0);
            const float* kb = kt + ((((size_t)g * 2 + 1) * 64 + (s > t ? s - t : 0)) * 256 + hp * 16 + h0);
            f32x4 a0, a1;
            if (s < t) { a0 = *(const f32x4*)kf; a1 = *(const f32x4*)(kf + 4); }
            else if (s > t) { a0 = *(const f32x4*)kb; a1 = *(const f32x4*)(kb + 4); }
            else { a0 = *(const f32x4*)kf + *(const f32x4*)kb; a1 = *(const f32x4*)(kf + 4) + *(const f32x4*)(kb + 4); }
            u32x4 w; w.x = pack2(a0[0], a0[1]); w.y = pack2(a0[2], a0[3]); w.z = pack2(a1[0], a1[1]); w.w = pack2(a1[2], a1[3]);
            *(u32x4*)(toep + ((size_t)g * 1024 + t * 16 + hp) * 1280 + s * 16 + h0) = w;
        }
        if (tid < 128) {
            const int dir = tid >> 6, p = tid & 63;
            const S5Base a = s5_base(c, l, dir, g, p);
            float ar, ai; s5_pow(a, dir ? 64 - t : t + 1, ar, ai);
            for (int hp = 0; hp < 16; ++hp) {
                const size_t ci = ((((size_t)l * 2 + dir) * 32 + g) * 16 + hp) * 64 + p;
                const float cr = c.p.in[I_S5CRE][ci], cim = c.p.in[I_S5CIM][ci];
                const float gr = cr * ar - cim * ai, gi = cr * ai + cim * ar;
                *(unsigned*)(toep + ((size_t)g * 1024 + t * 16 + hp) * 1280 + 1024 + dir * 128 + p * 2) = pack2(gr, -gi);
            }
        }
    }
    for (int it = c.bid; it < 32 * 2 * 8; it += c.nblk) {
        const int pb = it & 7, dir = (it >> 3) & 1, g = it >> 4, p = pb * 8 + (tid >> 6), sidx = tid & 63;
        const S5Base a = s5_base(c, l, dir, g, p);
        float ar, ai; s5_pow(a, dir ? sidx : 63 - sidx, ar, ai);
        float vr[16], vi[16];
#pragma unroll
        for (int h = 0; h < 16; ++h) {
            const size_t bi = ((((size_t)l * 2 + dir) * 32 + g) * 64 + p) * 16 + h;
            const float br = c.p.in[I_S5BRE][bi], bim = c.p.in[I_S5BIM][bi];
            const float bbr = a.fre * br - a.fim * bim, bbi = a.fre * bim + a.fim * br;
            vr[h] = ar * bbr - ai * bbi; vi[h] = ar * bbi + ai * bbr;
        }
        bf16_t* r0 = minm + ((size_t)g * 256 + dir * 128 + p * 2) * 1024 + sidx * 16;
        u32x4 w;
        w.x = pack2(vr[0], vr[1]); w.y = pack2(vr[2], vr[3]); w.z = pack2(vr[4], vr[5]); w.w = pack2(vr[6], vr[7]); *(u32x4*)r0 = w;
        w.x = pack2(vr[8], vr[9]); w.y = pack2(vr[10], vr[11]); w.z = pack2(vr[12], vr[13]); w.w = pack2(vr[14], vr[15]); *(u32x4*)(r0 + 8) = w;
        w.x = pack2(vi[0], vi[1]); w.y = pack2(vi[2], vi[3]); w.z = pack2(vi[4], vi[5]); w.w = pack2(vi[6], vi[7]); *(u32x4*)(r0 + 1024) = w;
        w.x = pack2(vi[8], vi[9]); w.y = pack2(vi[10], vi[11]); w.z = pack2(vi[12], vi[13]); w.w = pack2(vi[14], vi[15]); *(u32x4*)(r0 + 1024 + 8) = w;
    }
}
constexpr int S5_MT = (NCH + 63) / 64;
DEV void s5_local_item(const Ctx& c, int it) {
    const int g = it / S5_MT, m0 = (it % S5_MT) * 64;
    const bf16_t* ug = (const bf16_t*)(c.p.ws + WS::UG) + (size_t)g * NCH * 1280;
    const bf16_t* Bt = (const bf16_t*)(c.p.ws + WS::S5MIN) + (size_t)g * 256 * 1024;
    float* sloc = (float*)(c.p.ws + WS::SLOC) + (size_t)g * NCH * 256;
    f32x4 acc[GSmall::MI][GSmall::NI]; zero_acc<GSmall>(acc);
    gemm_acc<GSmall, true>(acc, [=](int m) -> const bf16_t* { return ug + (size_t)(m < NCH ? m : 0) * 1280; }, Bt, 1024, m0, 0, 1024, c.smem);
    epi_lds_f32<GSmall>(acc, m0, 0, c.smem, [=](int row, int col, f32x4 a, f32x4 b) { if (row < NCH) { *(f32x4*)(sloc + (size_t)row * 256 + col) = a; *(f32x4*)(sloc + (size_t)row * 256 + col + 4) = b; } });
}
DEV void s5_scan(const Ctx& c) {
    const float* a64 = (const float*)(c.p.ws + WS::S5A64) + (size_t)c.par * 2 * 32 * 64 * 2;
    constexpr int NCC = TC / S5L;
    static_assert(NCHB % 4 == 0, "scan unroll");
    for (int idx = c.bid * NTHR + TIDX; idx < NB * 32 * 2 * 64; idx += c.nblk * NTHR) {
        const int p = idx & 63, dir = (idx >> 6) & 1, g = (idx >> 7) & 31, b = idx >> 12;
        const float ar = a64[((dir * 32 + g) * 64 + p) * 2], ai = a64[((dir * 32 + g) * 64 + p) * 2 + 1];
        const float* __restrict__ sl = (const float*)(c.p.ws + WS::SLOC) + (size_t)g * NCH * 256 + dir * 128 + p * 2;
        bf16_t* __restrict__ so = (bf16_t*)(c.p.ws + WS::UG) + (size_t)g * NCH * 1280 + 1024 + dir * 128 + p * 2;
        auto order = [&](int j) { return s5_cr(b, dir == 0 ? j : (j < NCC ? NCC - 1 - j : NCHB - 1 - (j - NCC))); };
        float sr = 0.f, si = 0.f;
        constexpr int NG = NCHB / 4;
        float2 cur[4], n1[4], n2[4], nn[4];
#pragma unroll
        for (int u = 0; u < 4; ++u) { cur[u] = *(const float2*)(sl + (size_t)order(u) * 256); n1[u] = NG > 1 ? *(const float2*)(sl + (size_t)order(4 + u) * 256) : cur[u]; n2[u] = NG > 2 ? *(const float2*)(sl + (size_t)order(8 + u) * 256) : cur[u]; }
#pragma unroll 1
        for (int g2 = 0; g2 < NG; ++g2) {
            if (g2 + 3 < NG) {
#pragma unroll
                for (int u = 0; u < 4; ++u) nn[u] = *(const float2*)(sl + (size_t)order(4 * (g2 + 3) + u) * 256);
            }
#pragma unroll
            for (int u = 0; u < 4; ++u) {
                *(unsigned*)(so + (size_t)order(4 * g2 + u) * 1280) = pack2(sr, si);
                const float nr = ar * sr - ai * si + cur[u].x, ni = ar * si + ai * sr + cur[u].y;
                sr = nr; si = ni;
            }
#pragma unroll
            for (int u = 0; u < 4; ++u) { cur[u] = n1[u]; n1[u] = n2[u]; n2[u] = nn[u]; }
        }
    }
}
DEV float gelu_tanh(float x) { const float z = 0.7978845608028654f * (x + 0.044715f * x * x * x); const float t = 1.0f - 2.0f * frcp(1.0f + fexp(2.0f * z)); return 0.5f * x * (1.0f + t); }
template <class G> DEV void s5_out_tile(const Ctx& c, int l, int g, int m0, int n0) {
    const bf16_t* ug = (const bf16_t*)(c.p.ws + WS::UG) + (size_t)g * NCH * 1280;
    const bf16_t* Bt = (const bf16_t*)(c.p.ws + WS::S5TOEP) + (size_t)g * 1024 * 1280;
    bf16_t* yg = (bf16_t*)(c.p.ws + WS::YG);
    const float* dvec = c.p.in[I_S5D] + (size_t)l * 512 + g * 16;
    f32x4 acc[G::MI][G::NI]; zero_acc<G>(acc);
    gemm_acc<G, true>(acc, [=](int m) -> const bf16_t* { return ug + (size_t)(m < NCH ? m : 0) * 1280; }, Bt, 1280, m0, n0, 1280, c.smem);
    auto fin = [=](int row, int col, f32x4 a, f32x4 bq) -> u32x4 {
        f32x4 ua, ub; unpack8f(ldg16(ug + (size_t)row * 1280 + col), ua, ub);
        const int hp = col & 15;
        const f32x4 da = *(const f32x4*)(dvec + hp), db = *(const f32x4*)(dvec + hp + 4);
        f32x4 ya, yb2;
#pragma unroll
        for (int e = 0; e < 4; ++e) { ya[e] = gelu_tanh(a[e] + da[e] * ua[e]); yb2[e] = gelu_tanh(bq[e] + db[e] * ub[e]); }
        return pack8f(ya, yb2);
    };
    auto dstp = [=](int row, int col) -> bf16_t* { int b, pos0; s5_cr_inv(row, b, pos0); return yg + (size_t)bpos_row(b, pos0 + (col >> 4)) * 512 + g * 16 + (col & 15); };
    if constexpr (G::BM * (G::BN * 4 + 16) <= 160 * 1024 - 64) {
        epi_lds_f32<G>(acc, m0, n0, c.smem, [=](int row, int col, f32x4 a, f32x4 bq) { if (row < NCH) *(u32x4*)dstp(row, col) = fin(row, col, a, bq); });
    } else {
        epi_lds_bf16<G>(acc, m0, n0, c.smem,
            [=](int row, int col, f32x4 v) {
                const u32x2 ur = *(const u32x2*)(ug + (size_t)(row < NCH ? row : 0) * 1280 + col); const f32x4 d4 = *(const f32x4*)(dvec + (col & 15));
                f32x4 y;
                y[0] = gelu_tanh(v[0] + d4[0] * __uint_as_float(ur.x << 16)); y[1] = gelu_tanh(v[1] + d4[1] * __uint_as_float(ur.x & 0xffff0000u));
                y[2] = gelu_tanh(v[2] + d4[2] * __uint_as_float(ur.y << 16)); y[3] = gelu_tanh(v[3] + d4[3] * __uint_as_float(ur.y & 0xffff0000u));
                return y; },
            [=](int row, int col, u32x4 w) { if (row < NCH) *(u32x4*)dstp(row, col) = w; });
    }
}
constexpr bool S5_BIG = (NRL5 % 256 == 0);
constexpr int S5_BIG_IT = S5_BIG ? 32 * (NRL5 / 256) * 4 : 0, S5_SM_R0 = S5_BIG ? NRL5 : 0, S5_SM_MT = (NCH - S5_SM_R0 + 63) / 64, S5_SM_IT = 32 * S5_SM_MT * 4;
DEV void s5_out_item(const Ctx& c, int l, int it) {
    if (it < S5_BIG_IT) { const int nt = it & 3, mt = (it >> 2) % (NRL5 / 256), g = (it >> 2) / (NRL5 / 256); s5_out_tile<GBig>(c, l, g, mt * 256, nt * 256); }
    else { const int j = it - S5_BIG_IT, nt = j & 3, mt = (j >> 2) % S5_SM_MT, g = (j >> 2) / S5_SM_MT; s5_out_tile<GSmall>(c, l, g, S5_SM_R0 + mt * 64, nt * 256); }
}
template <class G> DEV void glu_tile(const Ctx& c, int m0, int n0) {
    const bf16_t* A = (const bf16_t*)(c.p.ws + WS::YG); const bf16_t* Bt = (const bf16_t*)(c.p.ws + WS::WGLU + (size_t)c.par * WS::WSET); bf16_t* yb = (bf16_t*)(c.p.ws + WS::YB);
    f32x4 acc[G::MI][G::NI]; zero_acc<G>(acc);
    gemm_acc<G>(acc, [=](int m) { return A + (size_t)m * 512; }, Bt, 512, m0, n0, 512, c.smem);
    epi_lds_f32<G>(acc, m0, n0, c.smem, [=](int row, int col, f32x4 a, f32x4 bq) {
        f32x4 ga, gb; unpack8f(ldg16(A + (size_t)row * 512 + col), ga, gb);
#pragma unroll
        for (int e = 0; e < 4; ++e) { ga[e] *= sigmoidf_(a[e]); gb[e] *= sigmoidf_(bq[e]); }
        *(u32x4*)(yb + (size_t)row * 512 + col) = pack8f(ga, gb);
    });
}
DEV void ml_out_item(const Ctx& c, int it);
constexpr int GLU_LT = (RL / 256) * 4, GLU_CT = (RC / 64) * 2, ML_CTX_IT = NB * 4 * NCMC;
DEV void phase_glu(const Ctx& c) {
    for (int j = c.nblk - 1 - c.bid; j < ML_CTX_IT; j += c.nblk) ml_out_item(c, (j / NCMC) * NCM + (j % NCMC));
    for (int rnd = 0;; ++rnd) {
        const int it = perm_slot(rnd, c.bid, c.nblk);
        if (it >= GLU_LT + GLU_CT) break;
        if (it < GLU_LT) { int mt, nt; grouped_tile(it, RL / 256, 4, mt, nt); glu_tile<GMid>(c, mt * 256, nt * 128); }
        else { const int j = it - GLU_LT; glu_tile<GSmall>(c, RL + (j % (RC / 64)) * 64, (j / (RC / 64)) * 256); }
    }
}

DEV int ml_order(int dir, int j) { return dir == 0 ? j : (j < NCMC ? NCMC - 1 - j : NCM - 1 - (j - NCMC)); }
DEV void unpack8(u32x4 raw, float (&x)[8]) {
#pragma unroll
    for (int e = 0; e < 4; ++e) { x[2 * e] = __uint_as_float(raw[e] << 16); x[2 * e + 1] = __uint_as_float(raw[e] & 0xffff0000u); }
}
DEV float wave_incl_scan_f(float v) {
    const int lane = TIDX & 63;
#pragma unroll
    for (int d = 1; d < 64; d <<= 1) { const float y = __shfl_up(v, d); if (lane >= d) v += y; }
    return v;
}
DEV void ml_local_item(const Ctx& c, int it) {
    unsigned char* ws = c.p.ws;
    const int tid = TIDX, lane = tid & 63, wave = tid >> 6, fr = lane & 31, fh = lane >> 5;
    const int cc = it % NCM, bh = it / NCM, pos0 = cc * MLC;
    LDSQ float* sm = (LDSQ float*)c.smem;
    LDSQ float* s_ew = sm;
    LDSQ float* s_x = sm + 256;
    LDSQ float* s_part = sm + 512;
    float wv = 0.f;
    {
        const int dir = (tid >> 7) & 1, t = tid & 127;
        float lfv = 0.f, igv = 0.f;
        if (tid < 256) { const size_t o = ((size_t)dir * NB * 4 + bh) * TK + pos0 + t; lfv = ((const float*)(ws + WS::MLF))[o]; igv = ((const float*)(ws + WS::MIG))[o]; }
        float inc = wave_incl_scan_f(lfv);
        if (tid < 256 && lane == 63) s_x[wave] = inc;
        __syncthreads();
        if (tid < 256) {
            const float lo = s_x[2 * dir], hi = s_x[2 * dir + 1], tot = lo + hi;
            if (wave & 1) inc += lo;
            const float cum = dir == 0 ? inc : tot - (inc - lfv);
            wv = tot - cum + igv;
            if (t == 0) s_x[8 + dir] = tot;
        }
        float m = wave_max(tid < 256 ? wv : -3.0e38f);
        if (tid < 256 && lane == 0) s_x[4 + wave] = m;
        __syncthreads();
        if (tid < 256) { const float mw = fmaxf(s_x[4 + 2 * dir], s_x[5 + 2 * dir]); s_ew[dir * 128 + t] = fexp(wv - mw); if (t == 0) s_x[10 + dir] = mw; }
        __syncthreads();
    }
    {
        const int vt = wave >> 1, kh = wave & 1;
        const bf16_t* vT = (const bf16_t*)(ws + WS::MVT) + ((size_t)bh * 128 + vt * 32 + fr) * TK + pos0 + fh * 8;
        const bf16_t* kT = (const bf16_t*)(ws + WS::MKT) + ((size_t)bh * 128 + kh * 64 + fr) * TK + pos0 + fh * 8;
        f32x16 acc[2][2];
#pragma unroll
        for (int r = 0; r < 16; ++r) { acc[0][0][r] = 0.f; acc[0][1][r] = 0.f; acc[1][0][r] = 0.f; acc[1][1][r] = 0.f; }
#pragma unroll 2
        for (int ks = 0; ks < 8; ++ks) {
            float x[8]; unpack8(ldg16(vT + ks * 16), x);
            const bf16x8 k0 = as_bf8(ldg16(kT + ks * 16)), k1 = as_bf8(ldg16(kT + (size_t)32 * TK + ks * 16));
            const int sb = ks * 16 + fh * 8;
#pragma unroll
            for (int dir = 0; dir < 2; ++dir) {
                LDSQ const float* ew = s_ew + dir * 128 + sb;
                u32x4 w; w.x = pack2(x[0] * ew[0], x[1] * ew[1]); w.y = pack2(x[2] * ew[2], x[3] * ew[3]); w.z = pack2(x[4] * ew[4], x[5] * ew[5]); w.w = pack2(x[6] * ew[6], x[7] * ew[7]);
                const bf16x8 vf = as_bf8(w);
                acc[dir][0] = mfma32(k0, vf, acc[dir][0]);
                acc[dir][1] = mfma32(k1, vf, acc[dir][1]);
            }
        }
#pragma unroll
        for (int dir = 0; dir < 2; ++dir) {
            float* kv = (float*)(ws + WS::MKV) + (((size_t)dir * NB * 4 + bh) * NCM + cc) * 16384 + (size_t)(vt * 32 + fr) * 128 + kh * 64;
#pragma unroll
            for (int kt = 0; kt < 2; ++kt)
#pragma unroll
                for (int rg = 0; rg < 4; ++rg) *(f32x4*)(kv + kt * 32 + 8 * rg + 4 * fh) = (f32x4){acc[dir][kt][4 * rg], acc[dir][kt][4 * rg + 1], acc[dir][kt][4 * rg + 2], acc[dir][kt][4 * rg + 3]};
        }
    }
    {
        const int k = tid & 127, part = tid >> 7;
        const bf16_t* kk = (const bf16_t*)(ws + WS::MK) + ((size_t)bh * TK + pos0 + part * 32) * 128 + k;
        float a0 = 0.f, a1 = 0.f;
        for (int s2 = 0; s2 < 32; ++s2) { const float kvl = bf2f(kk[(size_t)s2 * 128]); a0 += s_ew[part * 32 + s2] * kvl; a1 += s_ew[128 + part * 32 + s2] * kvl; }
        s_part[part * 128 + k] = a0; s_part[512 + part * 128 + k] = a1;
    }
    __syncthreads();
    if (tid < 256) {
        const int dir = tid >> 7, k = tid & 127;
        const size_t o = ((size_t)dir * NB * 4 + bh) * NCM + cc;
        LDSQ const float* pp = s_part + dir * 512;
        ((float*)(ws + WS::MKS))[o * 128 + k] = pp[k] + pp[128 + k] + pp[256 + k] + pp[384 + k];
        if (k == 0) { float* gm = (float*)(ws + WS::MGM) + o * 4; gm[0] = s_x[8 + dir]; gm[1] = s_x[10 + dir]; }
    }
    __syncthreads();
}
DEV void ml_scan(const Ctx& c) {
    unsigned char* ws = c.p.ws;
    LDSQ float* s_a = (LDSQ float*)c.smem; LDSQ float* s_e = s_a + NCM;
    const int tid = TIDX;
    for (int blk = (c.bid + c.nblk - c.nblk / 2) % c.nblk; blk < 2 * NB * 4 * 8; blk += c.nblk) {
        const int combo = blk >> 3, e4 = (blk & 7) * NTHR + tid, dir = combo / (NB * 4);
        float* gm = (float*)(ws + WS::MGM) + (size_t)combo * NCM * 4;
        if (tid == 0) {
            float m = 0.f;
            for (int j = 0; j < NCM; ++j) {
                const int cc = ml_order(dir, j);
                const float g = gm[cc * 4], mw = gm[cc * 4 + 1];
                if ((blk & 7) == 0) gm[cc * 4 + 2] = m;
                const float mn = fmaxf(g + m, mw);
                s_a[j] = fexp(g + m - mn); s_e[j] = fexp(mw - mn); m = mn;
            }
        }
        __syncthreads();
        const float* __restrict__ kv = (const float*)(ws + WS::MKV) + (size_t)combo * NCM * 16384 + e4 * 4;
        bf16_t* __restrict__ c0 = (bf16_t*)(ws + WS::MC0) + (size_t)combo * NCM * 16384 + e4 * 4;
        const float* __restrict__ ksv = (const float*)(ws + WS::MKS) + (size_t)combo * NCM * 128 + e4 * 4;
        float* __restrict__ n0 = (float*)(ws + WS::MN0) + (size_t)combo * NCM * 128 + e4 * 4;
        f32x4 C = (f32x4){0.f, 0.f, 0.f, 0.f}, n = C;
        const f32x4 z4 = (f32x4){0.f, 0.f, 0.f, 0.f};
        f32x4 pre[4], p1[4], p2[4], nxt[4];
#pragma unroll
        for (int u = 0; u < 4; ++u) {
            pre[u] = u < NCM ? *(const f32x4*)(kv + (size_t)ml_order(dir, u) * 16384) : z4;
            p1[u] = 4 + u < NCM ? *(const f32x4*)(kv + (size_t)ml_order(dir, 4 + u) * 16384) : z4;
            p2[u] = 8 + u < NCM ? *(const f32x4*)(kv + (size_t)ml_order(dir, 8 + u) * 16384) : z4;
        }
#pragma unroll 1
        for (int j0 = 0; j0 < NCM; j0 += 4) {
#pragma unroll
            for (int u = 0; u < 4; ++u) nxt[u] = (j0 + 12 + u < NCM) ? *(const f32x4*)(kv + (size_t)ml_order(dir, j0 + 12 + u) * 16384) : z4;
#pragma unroll
            for (int u = 0; u < 4; ++u) {
                const int j = j0 + u;
                if (j < NCM) {
                    const int cc = ml_order(dir, j);
                    st_bf4(c0 + (size_t)cc * 16384, C);
                    const float a = s_a[j], e = s_e[j];
                    if (e4 < 32) { *(f32x4*)(n0 + (size_t)cc * 128) = n; n = n * a + *(const f32x4*)(ksv + (size_t)cc * 128) * e; }
                    C = C * a + pre[u] * e;
                }
            }
#pragma unroll
            for (int u = 0; u < 4; ++u) { pre[u] = p1[u]; p1[u] = p2[u]; p2[u] = nxt[u]; }
        }
        __syncthreads();
    }
}
constexpr int ML_KS = 0, ML_VS = 128 * 272, ML_CS = 2 * 128 * 272, ML_QS = 3 * 128 * 272, ML_TAB = 4 * 128 * 272;
DEV void ml_out_item(const Ctx& c, int it) {
    unsigned char* ws = c.p.ws;
    const int tid = TIDX, lane = tid & 63, wave = tid >> 6, fr = lane & 31, fh = lane >> 5, tt = wave >> 1, vh = wave & 1;
    const int cc = it % NCM, bh = it / NCM, b = bh >> 2, head = bh & 3, pos0 = cc * MLC;
    LDSQ float* tab = (LDSQ float*)(c.smem + ML_TAB);
    {
        const bf16_t* mk = (const bf16_t*)(ws + WS::MK) + ((size_t)bh * TK + pos0) * 128;
        const bf16_t* mvt = (const bf16_t*)(ws + WS::MVT) + (size_t)bh * 128 * TK + pos0;
        const bf16_t* mq = (const bf16_t*)(ws + WS::MQ) + ((size_t)bh * TK + pos0) * 128;
#pragma unroll
        for (int i = 0; i < 4; ++i) {
            const int chunk = tid + NTHR * i, r = chunk >> 4, cc16 = chunk & 15;
            lds_st16(c.smem + ML_KS + r * 272 + cc16 * 16, ldg16(mk + (size_t)r * 128 + cc16 * 8));
            lds_st16(c.smem + ML_QS + r * 272 + cc16 * 16, ldg16(mq + (size_t)r * 128 + cc16 * 8));
            const u32x4 v = ldg16(mvt + (size_t)r * TK + cc16 * 8);
            const int q = cc16 >> 1, a = cc16 & 1;
            *(LDSQ u32x2*)(c.smem + ML_VS + r * 272 + (16 * q + 4 * a) * 2) = (u32x2){v.x, v.y};
            *(LDSQ u32x2*)(c.smem + ML_VS + r * 272 + (16 * q + 8 + 4 * a) * 2) = (u32x2){v.z, v.w};
        }
    }
    u32x4 c0r[4];
    {
        const bf16_t* c0g = (const bf16_t*)(ws + WS::MC0) + (((size_t)0 * NB * 4 + bh) * NCM + cc) * 16384;
#pragma unroll
        for (int i = 0; i < 4; ++i) { const int chunk = tid + NTHR * i; c0r[i] = ldg16(c0g + (size_t)(chunk >> 4) * 128 + (chunk & 15) * 8); }
        const int dir = (tid >> 7) & 1;
        float lfv = 0.f, igv = 0.f;
        if (tid < 256) { const size_t o = ((size_t)dir * NB * 4 + bh) * TK + pos0 + (tid & 127); lfv = ((const float*)(ws + WS::MLF))[o]; igv = ((const float*)(ws + WS::MIG))[o]; }
        float inc = wave_incl_scan_f(lfv);
        if (tid < 256 && lane == 63) tab[896 + wave] = inc;
        __syncthreads();
        if (tid < 256) {
            const float lo = tab[896 + 2 * dir], hi = tab[897 + 2 * dir];
            if (wave & 1) inc += lo;
            tab[tid] = dir == 0 ? inc : (lo + hi) - (inc - lfv);
            tab[256 + tid] = igv;
        }
    }
    __syncthreads();
    lds_t qb = c.smem + ML_QS + (tt * 32 + fr) * 272 + fh * 16;
    f32x16 S[4];
#pragma unroll
    for (int st = 0; st < 4; ++st) {
#pragma unroll
        for (int r = 0; r < 16; ++r) S[st][r] = 0.f;
#pragma unroll
        for (int ks = 0; ks < 8; ++ks) S[st] = mfma32(as_bf8(lds_ld16(c.smem + ML_KS + (32 * st + fr) * 272 + (2 * ks + fh) * 16)), as_bf8(lds_ld16(qb + ks * 32)), S[st]);
    }
    f32x16 hs[2];
#pragma unroll
    for (int r = 0; r < 16; ++r) { hs[0][r] = 0.f; hs[1][r] = 0.f; }
    const int t = tt * 32 + fr;
#pragma unroll 1
    for (int dir = 0; dir < 2; ++dir) {
        const size_t so = ((size_t)dir * NB * 4 + bh) * NCM + cc;
        __syncthreads();
        {
#pragma unroll
            for (int i = 0; i < 4; ++i) { const int chunk = tid + NTHR * i, r = chunk >> 4, cc16 = chunk & 15; lds_st16(c.smem + ML_CS + r * 272 + cc16 * 16, c0r[i]); }
            if (tid < 128) tab[512 + tid] = ((const float*)(ws + WS::MN0))[so * 128 + tid];
            if (dir == 0) {
                const bf16_t* c0g = (const bf16_t*)(ws + WS::MC0) + (((size_t)1 * NB * 4 + bh) * NCM + cc) * 16384;
#pragma unroll
                for (int i = 0; i < 4; ++i) { const int chunk = tid + NTHR * i; c0r[i] = ldg16(c0g + (size_t)(chunk >> 4) * 128 + (chunk & 15) * 8); }
            }
        }
        __syncthreads();
        const float m0 = ((const float*)(ws + WS::MGM))[so * 4 + 2];
        const float cumt = tab[dir * 128 + t], inter = cumt + m0;
        float mx = inter;
#pragma unroll
        for (int st = 0; st < 4; ++st)
#pragma unroll
            for (int r = 0; r < 16; ++r) {
                const int s2 = 32 * st + (r & 3) + 8 * (r >> 2) + 4 * fh;
                const bool ok = dir == 0 ? s2 <= t : s2 >= t;
                const float d = cumt - tab[dir * 128 + s2] + tab[256 + dir * 128 + s2];
                mx = ok ? fmaxf(mx, d) : mx;
            }
        mx = fmaxf(mx, __shfl_xor(mx, 32));
        const float ei = fexp(inter - mx);
        f32x16 acc[2];
#pragma unroll
        for (int r = 0; r < 16; ++r) { acc[0][r] = 0.f; acc[1][r] = 0.f; }
        float nq = 0.f;
#pragma unroll
        for (int ks = 0; ks < 8; ++ks) {
            const bf16x8 qk = as_bf8(lds_ld16(qb + ks * 32));
            acc[0] = mfma32(as_bf8(lds_ld16(c.smem + ML_CS + (64 * vh + fr) * 272 + (2 * ks + fh) * 16)), qk, acc[0]);
            acc[1] = mfma32(as_bf8(lds_ld16(c.smem + ML_CS + (64 * vh + 32 + fr) * 272 + (2 * ks + fh) * 16)), qk, acc[1]);
#pragma unroll
            for (int e = 0; e < 8; ++e) nq += tab[512 + ks * 16 + fh * 8 + e] * bf2f((bf16_t)qk[e]);
        }
        nq += __shfl_xor(nq, 32);
#pragma unroll
        for (int r = 0; r < 16; ++r) { acc[0][r] *= ei; acc[1][r] *= ei; }
        float den = 0.f;
#pragma unroll
        for (int st = 0; st < 4; ++st) {
            float w[16];
#pragma unroll
            for (int r = 0; r < 16; ++r) {
                const int s2 = 32 * st + (r & 3) + 8 * (r >> 2) + 4 * fh;
                const bool ok = dir == 0 ? s2 <= t : s2 >= t;
                const float d = cumt - tab[dir * 128 + s2] + tab[256 + dir * 128 + s2];
                w[r] = ok ? fexp(d - mx) * S[st][r] : 0.f;
                den += w[r];
            }
#pragma unroll
            for (int k2 = 0; k2 < 2; ++k2) {
                u32x4 pw; pw.x = pack2(w[8 * k2], w[8 * k2 + 1]); pw.y = pack2(w[8 * k2 + 2], w[8 * k2 + 3]); pw.z = pack2(w[8 * k2 + 4], w[8 * k2 + 5]); pw.w = pack2(w[8 * k2 + 6], w[8 * k2 + 7]);
                const bf16x8 pf = as_bf8(pw);
                acc[0] = mfma32(as_bf8(lds_ld16(c.smem + ML_VS + (64 * vh + fr) * 272 + (4 * st + 2 * k2 + fh) * 16)), pf, acc[0]);
                acc[1] = mfma32(as_bf8(lds_ld16(c.smem + ML_VS + (64 * vh + 32 + fr) * 272 + (4 * st + 2 * k2 + fh) * 16)), pf, acc[1]);
            }
        }
        den += __shfl_xor(den, 32);
        den += ei * nq;
        const float rd = 1.0f / fmaxf(fabsf(den), fexp(-mx));
#pragma unroll
        for (int r = 0; r < 16; ++r) { hs[0][r] += acc[0][r] * rd; hs[1][r] += acc[1][r] * rd; }
    }
    {
        const int row = bpos_row(b, pos0 + t);
        const bf16_t* po = (const bf16_t*)(ws + WS::PBUF) + (size_t)row * LDP + 3584 + head * 128;
        bf16_t* yc = (bf16_t*)(ws + WS::YC) + (size_t)row * 512 + head * 128;
#pragma unroll
        for (int vt = 0; vt < 2; ++vt)
#pragma unroll
            for (int rg = 0; rg < 4; ++rg) {
                const int v = 64 * vh + 32 * vt + 8 * rg + 4 * fh;
                const u32x2 og = *(const u32x2*)(po + v);
                f32x4 y;
                y[0] = hs[vt][4 * rg] * sigmoidf_(__uint_as_float(og.x << 16)); y[1] = hs[vt][4 * rg + 1] * sigmoidf_(__uint_as_float(og.x & 0xffff0000u));
                y[2] = hs[vt][4 * rg + 2] * sigmoidf_(__uint_as_float(og.y << 16)); y[3] = hs[vt][4 * rg + 3] * sigmoidf_(__uint_as_float(og.y & 0xffff0000u));
                st_bf4(yc + v, y);
            }
    }
    __syncthreads();
}

template <class G> DEV void branch_tile(const Ctx& c, int m0, int n0) {
    unsigned char* ws = c.p.ws;
    const bf16_t* P = (const bf16_t*)(ws + WS::PBUF); bf16_t* mixed = (bf16_t*)(ws + WS::MIXED);
    {
        constexpr int CPR = G::BN / 8, NCHK = G::BM * CPR / NTHR, RSF = G::BN * 4 + 16;
        f32x4 ta[NCHK], tb[NCHK];
#pragma unroll
        for (int q = 0; q < NCHK; ++q) { ta[q] = (f32x4){0.f, 0.f, 0.f, 0.f}; tb[q] = ta[q]; }
        const int tid = TIDX;
#pragma unroll 1
        for (int i = 0; i < 3; ++i) {
            const bf16_t* Y = (const bf16_t*)(ws + WS::YA + (size_t)i * WS::Y_SZ);
            const bf16_t* Bt = (const bf16_t*)(ws + WS::WBR + (size_t)c.par * WS::WSET) + (size_t)i * D * 512;
            f32x4 acc[G::MI][G::NI]; zero_acc<G>(acc);
            gemm_acc<G, false, 0, false>(acc, [=](int m) { return Y + (size_t)m * 512; }, Bt, 512, m0, n0, 512, c.smem);
            {
                const int lane = tid & 63, wave = tid >> 6, wm = wave / G::WN, wn = wave % G::WN;
#pragma unroll
                for (int mi = 0; mi < G::MI; ++mi)
#pragma unroll
                    for (int ni = 0; ni < G::NI; ++ni)
                        *(LDSQ f32x4*)(c.smem + (wm * 32 * G::MT + mi * 16 + (lane & 15)) * RSF + (wn * 32 * G::NT + ni * 16 + 4 * (lane >> 4)) * 4) = acc[mi][ni];
            }
            __syncthreads();
#pragma unroll
            for (int q = 0; q < NCHK; ++q) {
                const int id = tid + NTHR * q, rl = id / CPR, cc = id % CPR;
                f32x4 ga, gb; unpack8f(ldg16(P + (size_t)(m0 + rl) * LDP + 4096 + i * D + n0 + cc * 8), ga, gb);
                const f32x4 a = *(LDSQ const f32x4*)(c.smem + rl * RSF + cc * 32), bq = *(LDSQ const f32x4*)(c.smem + rl * RSF + cc * 32 + 16);
#pragma unroll
                for (int e = 0; e < 4; ++e) { ta[q][e] += sigmoidf_(ga[e]) * a[e]; tb[q][e] += sigmoidf_(gb[e]) * bq[e]; }
#ifndef EMU
                if (q & 1) __builtin_amdgcn_sched_barrier(0);
#endif
            }
            __syncthreads();
        }
#pragma unroll
        for (int q = 0; q < NCHK; ++q) { const int id = tid + NTHR * q, rl = id / CPR, cc = id % CPR; *(u32x4*)(mixed + (size_t)(m0 + rl) * D + n0 + cc * 8) = pack8f(ta[q], tb[q]); }
    }
}
constexpr int GM_LT = (RL / 256) * (D / 128), GM_CT = (RC / 64) * (D / 256);
DEV void phase_branch(const Ctx& c) {
    for (int rnd = 0;; ++rnd) {
        const int it = perm_slot(rnd, c.bid, c.nblk);
        if (it >= GM_LT + GM_CT) break;
        if (it < GM_LT) { int mt, nt; grouped_tile(it, RL / 256, D / 128, mt, nt); branch_tile<GMid>(c, mt * 256, nt * 128); }
        else { const int j = it - GM_LT; branch_tile<GSmall>(c, RL + (j % (RC / 64)) * 64, (j / (RC / 64)) * 256); }
    }
}
template <class G> DEV void out_tile(const Ctx& c, int l, int m0, int n0) {
    unsigned char* ws = c.p.ws;
    const bf16_t* A = (const bf16_t*)(ws + WS::MIXED); const bf16_t* Bt = (const bf16_t*)(ws + WS::WOUT + (size_t)c.par * WS::WSET);
    float* xc = (float*)(ws + WS::XCUR); const float* modv = (const float*)(ws + WS::MODV) + (size_t)l * 3 * 6 * D;
    f32x4 acc[G::MI][G::NI]; zero_acc<G>(acc);
    gemm_acc<G>(acc, [=](int m) { return A + (size_t)m * D; }, Bt, D, m0, n0, D, c.smem);
    epi_lds_f32<G>(acc, m0, n0, c.smem, [=](int row, int col, f32x4 a, f32x4 bq) {
        const float* gp = modv + (size_t)row_cond(row) * 6 * D + 2 * D + col;
        f32x4* xp = (f32x4*)(xc + (size_t)row * D + col);
        xp[0] = xp[0] + *(const f32x4*)gp * a; xp[1] = xp[1] + *(const f32x4*)(gp + 4) * bq;
    });
}
DEV void phase_out(const Ctx& c, int l) {
    for (int rnd = 0;; ++rnd) {
        const int it = perm_slot(rnd, c.bid, c.nblk);
        if (it >= GM_LT + GM_CT) break;
        if (it < GM_LT) { int mt, nt; grouped_tile(it, RL / 256, D / 128, mt, nt); out_tile<GMid>(c, l, mt * 256, nt * 128); }
        else { const int j = it - GM_LT; out_tile<GSmall>(c, l, RL + (j % (RC / 64)) * 64, (j / (RC / 64)) * 256); }
    }
}
DEV void phase_norm2_router(const Ctx& c, int l) {
    const int tid = TIDX, lane = tid & 63, wave = tid >> 6;
    const float* xc = (const float*)(c.p.ws + WS::XCUR);
    bf16_t* dst = (bf16_t*)(c.p.ws + WS::A1);
    const float* modv = (const float*)(c.p.ws + WS::MODV) + (size_t)l * 3 * 6 * D;
    const float* wr = c.p.in[I_WR] + (size_t)l * D * NE;
    float* aff = (float*)(c.p.ws + WS::AFF);
    constexpr int NV = D / 256;
    for (int idx = tid; idx < D * 4; idx += NTHR) {
        const int k = idx >> 2, e4 = idx & 3, kk = ((k >> 8) * 4 + (k & 3)) * 64 + ((k & 255) >> 2);
        *(LDSQ f32x4*)(c.smem + kk * 80 + e4 * 16) = *(const f32x4*)(wr + (size_t)k * NE + e4 * 4);
    }
    __syncthreads();
    const int stride = c.nblk * 8;
    int row = c.bid * 8 + wave;
    f32x4 cur[NV], nxt[NV];
    if (row < R) {
#pragma unroll
        for (int i = 0; i < NV; ++i) cur[i] = *(const f32x4*)(xc + (size_t)row * D + i * 256 + lane * 4);
    }
    for (; row < R; row += stride) {
        const int nrow = row + stride;
        if (nrow < R) {
#pragma unroll
            for (int i = 0; i < NV; ++i) nxt[i] = *(const f32x4*)(xc + (size_t)nrow * D + i * 256 + lane * 4);
        }
        float ss = 0.f;
#pragma unroll
        for (int i = 0; i < NV; ++i) ss += cur[i][0] * cur[i][0] + cur[i][1] * cur[i][1] + cur[i][2] * cur[i][2] + cur[i][3] * cur[i][3];
        ss = wave_sum(ss);
        const float inv = 1.0f / sqrtf(ss * (1.0f / D) + EPS);
        const float* mv = modv + (size_t)row_cond(row) * 6 * D + 3 * D;
        float v[16];
#pragma unroll
        for (int e = 0; e < 16; ++e) v[e] = 0.f;
#pragma unroll
        for (int i = 0; i < NV; ++i) {
            const int col = i * 256 + lane * 4;
            const f32x4 h = cur[i] * inv * (*(const f32x4*)(mv + D + col) + 1.0f) + *(const f32x4*)(mv + col);
            st_bf4(dst + (size_t)row * D + col, h);
#pragma unroll
            for (int q = 0; q < 4; ++q) {
                lds_t wp = c.smem + ((i * 4 + q) * 64 + lane) * 80;
#pragma unroll
                for (int e4 = 0; e4 < 4; ++e4) { const f32x4 w4 = *(LDSQ const f32x4*)(wp + e4 * 16); v[e4 * 4] += h[q] * w4[0]; v[e4 * 4 + 1] += h[q] * w4[1]; v[e4 * 4 + 2] += h[q] * w4[2]; v[e4 * 4 + 3] += h[q] * w4[3]; }
            }
        }
#pragma unroll
        for (int j = 0; j < 8; ++j) { const bool hi = (lane & 32) != 0; const float send = hi ? v[j] : v[j + 8], keep = hi ? v[j + 8] : v[j]; v[j] = keep + __shfl_xor(send, 32); }
#pragma unroll
        for (int j = 0; j < 4; ++j) { const bool hi = (lane & 16) != 0; const float send = hi ? v[j] : v[j + 4], keep = hi ? v[j + 4] : v[j]; v[j] = keep + __shfl_xor(send, 16); }
#pragma unroll
        for (int j = 0; j < 2; ++j) { const bool hi = (lane & 8) != 0; const float send = hi ? v[j] : v[j + 2], keep = hi ? v[j + 2] : v[j]; v[j] = keep + __shfl_xor(send, 8); }
        { const bool hi = (lane & 4) != 0; const float send = hi ? v[0] : v[1], keep = hi ? v[1] : v[0]; v[0] = keep + __shfl_xor(send, 4); }
        float lg = v[0]; lg += __shfl_xor(lg, 1); lg += __shfl_xor(lg, 2);
        float mx = lg; mx = fmaxf(mx, __shfl_xor(mx, 4)); mx = fmaxf(mx, __shfl_xor(mx, 8)); mx = fmaxf(mx, __shfl_xor(mx, 16)); mx = fmaxf(mx, __shfl_xor(mx, 32));
        const float ex = expf(lg - mx);
        float sm = ex; sm += __shfl_xor(sm, 4); sm += __shfl_xor(sm, 8); sm += __shfl_xor(sm, 16); sm += __shfl_xor(sm, 32);
        int b, pos; row_bpos(row, b, pos);
        const int e = ((lane >> 5) & 1) * 8 + ((lane >> 4) & 1) * 4 + ((lane >> 3) & 1) * 2 + ((lane >> 2) & 1);
        if ((lane & 3) == 0) aff[((size_t)b * NE + e) * TK + pos] = ex / sm;
#pragma unroll
        for (int i = 0; i < NV; ++i) cur[i] = nxt[i];
    }
    __syncthreads();
}
DEV unsigned wave_excl_scan(unsigned v, unsigned& total) {
    const int lane = TIDX & 63;
    unsigned x = v;
#pragma unroll
    for (int d = 1; d < 64; d <<= 1) { const unsigned y = __shfl_up(x, d); if (lane >= d) x += y; }
    total = __shfl(x, 63);
    return x - v;
}
DEV void phase_topk(const Ctx& c) {
    unsigned char* ws = c.p.ws;
    const int tid = TIDX, lane = tid & 63, wave = tid >> 6;
    LDSQ unsigned* hist = (LDSQ unsigned*)c.smem;
    LDSQ unsigned* sh = (LDSQ unsigned*)(c.smem + 1024);
    int* selrow = (int*)(ws + WS::SELROW); float* selaff = (float*)(ws + WS::SELAFF); int* tokslot = (int*)(ws + WS::TOKSLOT);
    constexpr int EL = T / NTHR;
    static_assert(T % NTHR == 0 && TC <= NTHR, "top-k element ownership");
    for (int it = c.bid; it < 2 * NB * NE; it += c.nblk) {
        const int seg = it / (NB * NE), b = (it / NE) % NB, e = it % NE;
        const int n = seg ? TC : T, cap = seg ? CAPC : CAPL, pos_off = seg ? 0 : TC, ne = seg ? 1 : EL, i0 = tid * ne;
        const float* av = (const float*)(ws + WS::AFF) + ((size_t)b * NE + e) * TK + pos_off;
        unsigned key[EL];
        if (seg == 0) {
            if constexpr (EL % 4 == 0) {
#pragma unroll
                for (int q = 0; q < EL / 4; ++q) { const u32x4 w = *(const u32x4*)(av + i0 + 4 * q); key[4 * q] = w.x; key[4 * q + 1] = w.y; key[4 * q + 2] = w.z; key[4 * q + 3] = w.w; }
            } else {
#pragma unroll
                for (int q = 0; q < EL; ++q) key[q] = __float_as_uint(av[i0 + q]);
            }
        } else {
#pragma unroll
            for (int q = 0; q < EL; ++q) key[q] = 0u;
            if (tid < n) key[0] = __float_as_uint(av[tid]);
        }
        const bool act = i0 < n;
        unsigned prefix = 0u, remaining = (unsigned)cap;
#pragma unroll 1
        for (int pass = 0; pass < 4; ++pass) {
            const int shift = 24 - 8 * pass;
            if (tid < 256) hist[tid] = 0u;
            __syncthreads();
            const unsigned himask = pass == 0 ? 0u : (0xffffffffu << (shift + 8));
            if (act) {
#pragma unroll
                for (int q = 0; q < EL; ++q) if (q < ne && (key[q] & himask) == prefix) lds_inc(&hist[(key[q] >> shift) & 255u]);
            }
            __syncthreads();
            unsigned hv = tid < 256 ? hist[255 - tid] : 0u, tot;
            const unsigned ex = wave_excl_scan(hv, tot);
            if (lane == 0) sh[wave] = tot;
            __syncthreads();
            unsigned base = 0u;
            for (int w = 0; w < 4; ++w) if (w < wave) base += sh[w];
            const unsigned above = base + ex;
            if (tid < 256 && above < remaining && above + hv >= remaining) { sh[8] = 255u - (unsigned)tid; sh[9] = remaining - above; }
            __syncthreads();
            prefix |= sh[8] << shift; remaining = sh[9];
            __syncthreads();
        }
        const unsigned thr = prefix, need = remaining;
        unsigned ngt = 0u, neq = 0u;
        if (act) {
#pragma unroll
            for (int q = 0; q < EL; ++q) if (q < ne) { ngt += key[q] > thr ? 1u : 0u; neq += key[q] == thr ? 1u : 0u; }
        }
        unsigned tg, te;
        const unsigned xg = wave_excl_scan(ngt, tg), xe = wave_excl_scan(neq, te);
        if (lane == 0) { sh[16 + wave] = tg; sh[24 + wave] = te; }
        __syncthreads();
        unsigned gt_before = xg, eq_before = xe;
        for (int w = 0; w < 8; ++w) if (w < wave) { gt_before += sh[16 + w]; eq_before += sh[24 + w]; }
        const int er0 = seg ? MEL + b * CAPC : b * CAPL;
        if (act) {
            unsigned slot = gt_before + (eq_before < need ? eq_before : need), eqr = eq_before;
#pragma unroll
            for (int q = 0; q < EL; ++q) if (q < ne) {
                const unsigned k = key[q];
                const bool sel = k > thr || (k == thr && eqr < need);
                if (k == thr) ++eqr;
                const int row = bpos_row(b, pos_off + i0 + q);
                if (sel) { const int er = er0 + (int)slot; selrow[e * MEP + er] = row; selaff[e * MEP + er] = __uint_as_float(k); tokslot[(size_t)row * NE + e] = er; ++slot; }
                else tokslot[(size_t)row * NE + e] = -1;
            }
        }
        if (seg == 1 && b == 0) for (int i = MEL + MEC + tid; i < MEP; i += NTHR) { selrow[e * MEP + i] = -1; selaff[e * MEP + i] = 0.f; }
        __syncthreads();
    }
}
template <class G> DEV void moe1_tile(const Ctx& c, int e, int m0, int n0) {
    unsigned char* ws = c.p.ws;
    const bf16_t* h2 = (const bf16_t*)(ws + WS::A1); const int* selrow = (const int*)(ws + WS::SELROW) + e * MEP;
    const bf16_t* Bt = (const bf16_t*)(ws + WS::WGU + (size_t)c.par * WS::WSET) + (size_t)e * 2 * DE * D;
    bf16_t* hid = (bf16_t*)(ws + WS::HID) + (size_t)e * MEP * DE;
    f32x4 acc[G::MI][G::NI]; zero_acc<G>(acc);
    gemm_acc<G, true>(acc, [=](int m) -> const bf16_t* { const int r = selrow[m]; return h2 + (size_t)(r >= 0 ? r : 0) * D; }, Bt, D, m0, n0, D, c.smem);
    constexpr int HN = G::BN / 2, RSE = HN * 2 + 16;
    const int tid = TIDX, lane = tid & 63, wave = tid >> 6, wm = wave / G::WN, wn = wave % G::WN;
#pragma unroll
    for (int mi = 0; mi < G::MI; ++mi) {
        const int rl = wm * 32 * G::MT + mi * 16 + (lane & 15);
#pragma unroll
        for (int np = 0; np < G::NI / 2; ++np) {
            const int hl = (wn * 32 * G::NT) / 2 + np * 16 + 4 * (lane >> 4);
            f32x4 y;
#pragma unroll
            for (int q = 0; q < 4; ++q) y[q] = siluf_(acc[mi][2 * np][q]) * acc[mi][2 * np + 1][q];
            u32x2 w; w.x = pack2(y[0], y[1]); w.y = pack2(y[2], y[3]);
            *(LDSQ u32x2*)(c.smem + rl * RSE + hl * 2) = w;
        }
    }
    __syncthreads();
    constexpr int CPR = HN / 8;
#pragma unroll 4
    for (int id = tid; id < G::BM * CPR; id += NTHR) { const int rl = id / CPR, cc = id % CPR; *(u32x4*)(hid + (size_t)(m0 + rl) * DE + n0 / 2 + cc * 8) = lds_ld16(c.smem + rl * RSE + cc * 16); }
    __syncthreads();
}
template <class G> DEV void moe2_tile(const Ctx& c, int e, int m0, int n0) {
    unsigned char* ws = c.p.ws;
    const bf16_t* hid = (const bf16_t*)(ws + WS::HID) + (size_t)e * MEP * DE; const float* selaff = (const float*)(ws + WS::SELAFF) + e * MEP;
    const bf16_t* Bt = (const bf16_t*)(ws + WS::WDN + (size_t)c.par * WS::WSET) + (size_t)e * D * DE;
    bf16_t* ys = (bf16_t*)(ws + WS::YS) + (size_t)e * MEP * D;
    f32x4 acc[G::MI][G::NI]; zero_acc<G>(acc);
    gemm_acc<G>(acc, [=](int m) { return hid + (size_t)m * DE; }, Bt, DE, m0, n0, DE, c.smem);
    epi_lds_bf16<G>(acc, m0, n0, c.smem, [=](int row, int col, f32x4 v) { return v * selaff[row]; }, [=](int row, int col, u32x4 w) { *(u32x4*)(ys + (size_t)row * D + col) = w; });
}
template <int BM> struct MoeG { typedef GSmall type; };
template <> struct MoeG<256> { typedef GBig type; };
typedef MoeG<MOE_BM>::type GMoe;
constexpr int MOE_LT = MEL / MOE_BM, MOE_CT = (MEP - MEL) / 64;
DEV void phase_moe1(const Ctx& c) {
    constexpr int NNT = 2 * DE / 256, TPE = MOE_LT * NNT, NL_IT = NE * TPE, NC_IT = NE * MOE_CT * NNT;
    for (int rnd = 0;; ++rnd) {
        const int it = perm_slot(rnd, c.bid, c.nblk);
        if (it >= NL_IT + NC_IT) break;
        if (it < NL_IT) { int mt, nt; grouped_tile(it % TPE, MOE_LT, NNT, mt, nt); moe1_tile<GMoe>(c, it / TPE, mt * MOE_BM, nt * 256); }
        else { const int j = it - NL_IT, mt = j % MOE_CT, nt = (j / MOE_CT) % NNT, e = j / (MOE_CT * NNT); moe1_tile<GSmall>(c, e, MEL + mt * 64, nt * 256); }
    }
}
DEV void phase_moe2(const Ctx& c) {
    constexpr int NNT = D / 256, TPE = MOE_LT * NNT, NL_IT = NE * TPE, NC_IT = NE * MOE_CT * NNT;
    for (int rnd = 0;; ++rnd) {
        const int it = perm_slot(rnd, c.bid, c.nblk);
        if (it >= NL_IT + NC_IT) break;
        if (it < NL_IT) { int mt, nt; grouped_tile(it % TPE, MOE_LT, NNT, mt, nt); moe2_tile<GMoe>(c, it / TPE, mt * MOE_BM, nt * 256); }
        else { const int j = it - NL_IT, mt = j % MOE_CT, nt = (j / MOE_CT) % NNT, e = j / (MOE_CT * NNT); moe2_tile<GSmall>(c, e, MEL + mt * 64, nt * 256); }
    }
}
DEV void phase_combine(const Ctx& c, int l) {
    unsigned char* ws = c.p.ws;
    const int tid = TIDX, lane = tid & 63, wave = tid >> 6;
    float* xc = (float*)(ws + WS::XCUR); const float* modv = (const float*)(ws + WS::MODV) + (size_t)l * 3 * 6 * D;
    const int* tokslot = (const int*)(ws + WS::TOKSLOT); const bf16_t* ys = (const bf16_t*)(ws + WS::YS);
    bf16_t* a1 = (bf16_t*)(ws + WS::A1);
    constexpr int NV = D / 256;
    const int stride = c.nblk * 8;
    int row = c.bid * 8 + wave;
    int myslot = -1, nslot = -1;
    f32x4 xv[NV], nx[NV];
    if (row < R) {
        myslot = tokslot[(size_t)row * NE + (lane & 15)];
#pragma unroll
        for (int i = 0; i < NV; ++i) xv[i] = *(const f32x4*)(xc + (size_t)row * D + i * 256 + lane * 4);
    }
    for (; row < R; row += stride, myslot = nslot) {
        const int nrow = row + stride;
        if (nrow < R) {
            nslot = tokslot[(size_t)nrow * NE + (lane & 15)];
#pragma unroll
            for (int i = 0; i < NV; ++i) nx[i] = *(const f32x4*)(xc + (size_t)nrow * D + i * 256 + lane * 4);
        }
        f32x4 acc[NV];
#pragma unroll
        for (int i = 0; i < NV; ++i) acc[i] = (f32x4){0.f, 0.f, 0.f, 0.f};
#pragma unroll 4
        for (int e = 0; e < NE; ++e) {
            const int sl = __shfl(myslot, e);
            if (sl >= 0) {
                const bf16_t* yr = ys + ((size_t)e * MEP + sl) * D;
#pragma unroll
                for (int i = 0; i < NV; ++i) { const u32x2 w = *(const u32x2*)(yr + i * 256 + lane * 4); acc[i][0] += __uint_as_float(w.x << 16); acc[i][1] += __uint_as_float(w.x & 0xffff0000u); acc[i][2] += __uint_as_float(w.y << 16); acc[i][3] += __uint_as_float(w.y & 0xffff0000u); }
            }
        }
        const int cond = row_cond(row);
        const float* g = modv + (size_t)cond * 6 * D + 5 * D;
        float ss = 0.f;
#pragma unroll
        for (int i = 0; i < NV; ++i) {
            const int col = i * 256 + lane * 4;
            xv[i] = xv[i] + *(const f32x4*)(g + col) * acc[i];
            *(f32x4*)(xc + (size_t)row * D + col) = xv[i];
            ss += xv[i][0] * xv[i][0] + xv[i][1] * xv[i][1] + xv[i][2] * xv[i][2] + xv[i][3] * xv[i][3];
        }
        if (l == NL - 1) {
            if (row < RL) {
#pragma unroll
                for (int i = 0; i < NV; ++i) *(f32x4*)(c.p.out + (size_t)row * D + i * 256 + lane * 4) = xv[i];
            }
        } else {
            ss = wave_sum(ss);
            const float inv = 1.0f / sqrtf(ss * (1.0f / D) + EPS);
            const float* mv = modv + 3 * 6 * D + (size_t)cond * 6 * D;
#pragma unroll
            for (int i = 0; i < NV; ++i) {
                const int col = i * 256 + lane * 4;
                st_bf4(a1 + (size_t)row * D + col, xv[i] * inv * (*(const f32x4*)(mv + D + col) + 1.0f) + *(const f32x4*)(mv + col));
            }
        }
#pragma unroll
        for (int i = 0; i < NV; ++i) xv[i] = nx[i];
    }
}

enum { PH_PROLOGUE = 0, PH_CONVERT, PH_NORM1, PH_INPROJ, PH_PREP, PH_MIX1, PH_SCAN, PH_MIX2, PH_GLU, PH_BRANCH, PH_OUT, PH_NORM2, PH_TOPK, PH_MOE1, PH_MOE2, PH_COMBINE, PH_FINAL, PH_COUNT };
#ifdef EMU
int emu_stop_layer = 1 << 30, emu_stop_phase = 1 << 30;
#endif

template <int PH> DEV void run_phase(const Ctx& c, int l) {
    if constexpr (PH == PH_PROLOGUE) { phase_prologue(c); phase_convert(c, 0); phase_s5_tab1(c, 0); }
    if constexpr (PH == PH_NORM1) { if (l == 0) phase_norm(c, 0, 0); if (l == 0 || SCHED_MODE == 1 || SCHED_MODE == 8 || SCHED_MODE == 3 || SCHED_MODE == 6 || SCHED_MODE == 7 || SCHED_MODE == 9 || SCHED_MODE == 10) phase_s5_tab2(c, l); }
    if constexpr (PH == PH_CONVERT) { if (SCHED_MODE == 1 || SCHED_MODE == 8 || SCHED_MODE == 4) { phase_convert(c, l); phase_s5_tab1(c, l); } if (SCHED_MODE == 6 || SCHED_MODE == 10) phase_convert(c, l); if (SCHED_MODE == 7) phase_s5_tab1(c, l); if (SCHED_MODE == 9) { phase_convert(c, l); phase_s5_tab1(c, l); } }
    if constexpr (PH == PH_INPROJ) { phase_inproj(c); if (PROBE_SUB == 10) probe_inproj<0>(c); if (PROBE_SUB == 11) probe_inproj<1>(c); if (PROBE_SUB == 12) probe_inproj<2>(c); if (PROBE_SUB == 13) probe_inproj<3>(c); }
    if constexpr (PH == PH_PREP) phase_prep(c, l);
    if constexpr (PH == PH_MIX1) phase_mix1(c, l);
    if constexpr (PH == PH_SCAN) {
        s5_scan(c); ml_scan(c);
        const int off = c.nblk / 2;
        if (SCHED_MODE == 10 && l + 1 < NL) { Ctx cu{c.p, c.smem, c.bid, c.nblk, (l + 1) & 1}; phase_s5_tab1(cu, l + 1); }
        if (SCHED_MODE == 8 && c.bid >= off) { Ctx cu{c.p, c.smem, c.bid - off, c.nblk - off, l & 1}; phase_s5_tab1(cu, l); }
        if (SCHED_MODE != 1 && SCHED_MODE != 8 && SCHED_MODE != 10 && SCHED_MODE != 4 && l + 1 < NL && c.bid >= off) { Ctx cu{c.p, c.smem, c.bid - off, c.nblk - off, (l + 1) & 1}; if (SCHED_MODE != 6 && SCHED_MODE != 9) phase_convert(cu, l + 1); if (SCHED_MODE != 7) phase_s5_tab1(cu, l + 1); }
    }
    if constexpr (PH == PH_MIX2) { for (int rep = 0; rep < (PROBE_SUB == 4 ? 2 : 1); ++rep) for (int it = c.bid; it < S5_BIG_IT + S5_SM_IT; it += c.nblk) s5_out_item(c, l, it); for (int rep = 0; rep < (PROBE_SUB == 5 ? 2 : 1); ++rep) for (int j = c.bid; j < NB * 4 * (NCM - NCMC); j += c.nblk) ml_out_item(c, (j / (NCM - NCMC)) * NCM + NCMC + (j % (NCM - NCMC))); }
    if constexpr (PH == PH_GLU) phase_glu(c);
    if constexpr (PH == PH_BRANCH) phase_branch(c);
    if constexpr (PH == PH_OUT) phase_out(c, l);
    if constexpr (PH == PH_NORM2) phase_norm2_router(c, l);
    if constexpr (PH == PH_TOPK) {
        phase_topk(c);
        const int off = c.nblk / 4;
        if (SCHED_MODE != 1 && SCHED_MODE != 8 && SCHED_MODE != 3 && SCHED_MODE != 6 && SCHED_MODE != 7 && SCHED_MODE != 9 && SCHED_MODE != 10 && l + 1 < NL && c.bid >= off) { Ctx cu{c.p, c.smem, c.bid - off, c.nblk - off, (l + 1) & 1}; phase_s5_tab2(cu, l + 1); }
    }
    if constexpr (PH == PH_MOE1) phase_moe1(c);
    if constexpr (PH == PH_MOE2) phase_moe2(c);
    if constexpr (PH == PH_COMBINE) phase_combine(c, l);
}

#ifndef EMU
extern __shared__ __attribute__((aligned(16))) unsigned char smem_raw[];
#endif
constexpr int LDS_BYTES = 160 * 1024;

#ifdef EMU
#define GRID_SYNC() emu_grid_sync()
#else
#define GRID_SYNC() do { XcdBarrier bb = bar; asm volatile("" : "+s"(bb.bar), "+s"(bb.x)); xcd_barrier(bb); } while (0)
#endif
#ifdef EMU
#define LAUNDER(kq, ll, bb, nn)
#else
#define LAUNDER(kq, ll, bb, nn) asm volatile("" : "+s"(kq), "+s"(ll), "+s"(bb), "+s"(nn))
#endif
#ifdef EMU
#define PHMARK(PH)
#else
#define PHMARK(PH) asm volatile("; PHASE_MARK %0" :: "n"(PH))
#endif
#ifdef EMU
#define EMU_SKIP(PH, l) if (l > emu_stop_layer || (l == emu_stop_layer && PH > emu_stop_phase)) break;
#else
#define EMU_SKIP(PH, l)
#endif
#define RUN1(PH, l) do { EMU_SKIP(PH, l) PHMARK(PH); auto kq = kp; int ll = l, bb = bid0, nn = nblk0; LAUNDER(kq, ll, bb, nn); Ctx cc{*kq, smem, bb, nn, ll & 1}; run_phase<PH>(cc, ll); GRID_SYNC(); } while (0)
#define RUN(PH, l) do { RUN1(PH, l); if ((PROBE_MASK >> PH) & 1u) RUN1(PH, l); } while (0)
__global__ void __launch_bounds__(NTHR, 2) k_mega(Params p) {
#ifdef EMU
    const Params* kp = &p; lds_t smem = emu_smem();
#else
    const KAS Params* kp = (const KAS Params*)__builtin_amdgcn_kernarg_segment_ptr(); lds_t smem = (lds_t)smem_raw;
    volatile LAS unsigned* xbw = (volatile LAS unsigned*)(smem_raw + LDS_BYTES - 16);
    if (threadIdx.x == 0) { xbw[0] = 0u; xbw[1] = 0u; xbw[2] = 0u; xbw[3] = 0u; }
    __syncthreads();
    XcdBarrier bar = xcd_barrier_post((unsigned*)(kp->ws + WS::BAR), xbw);
#endif
    const int bid0 = blockIdx.x, nblk0 = gridDim.x;
    RUN(PH_PROLOGUE, 0); RUN(PH_NORM1, 0);
#pragma unroll 1
    for (int l = 0; l < NL; ++l) {
        if (SCHED_MODE != 0 && l > 0) { RUN(PH_CONVERT, l); RUN(PH_NORM1, l); }
        RUN(PH_INPROJ, l); RUN(PH_PREP, l); RUN(PH_MIX1, l); RUN(PH_SCAN, l); RUN(PH_MIX2, l); RUN(PH_GLU, l);
        RUN(PH_BRANCH, l);
        RUN1(PH_OUT, l);
        RUN(PH_NORM2, l); RUN(PH_TOPK, l); RUN(PH_MOE1, l); RUN(PH_MOE2, l);
        RUN1(PH_COMBINE, l);
    }
}

template <int PH> __global__ void __launch_bounds__(NTHR, 2) k_phase(Params p, int l) {
#ifdef EMU
    Ctx c{p, emu_smem(), (int)blockIdx.x, (int)gridDim.x, l & 1};
#else
    Ctx c{*(const KAS Params*)__builtin_amdgcn_kernarg_segment_ptr(), (lds_t)smem_raw, (int)blockIdx.x, (int)gridDim.x, l & 1};
#endif
    run_phase<PH>(c, l);
}

#ifdef EMU
template <int PH> static void emu_kphase(const void* a) { struct A { Params p; int l; }; const A* x = (const A*)a; k_phase<PH>(x->p, x->l); }
template <int PH> static void launch_phase(const Params& p, int l, int grid, hipStream_t) {
    if (l > emu_stop_layer || (l == emu_stop_layer && PH > emu_stop_phase)) return;
    struct A { Params p; int l; } a{p, l}; emu_launch(emu_kphase<PH>, &a, grid, NTHR, LDS_BYTES);
}
#else
template <int PH> static void launch_phase(const Params& p, int l, int grid, hipStream_t s) {
    static bool attr = false;
    if (!attr) { hipFuncSetAttribute((const void*)k_phase<PH>, hipFuncAttributeMaxDynamicSharedMemorySize, LDS_BYTES); attr = true; }
    hipLaunchKernelGGL(k_phase<PH>, dim3(grid), dim3(NTHR), LDS_BYTES, s, p, l);
}
#endif

extern "C" void kernel_launch(void* const* d_in, const int* in_sizes, int n_in, void* d_out, int out_size, void* d_ws, size_t ws_size, hipStream_t stream) {
    Params p{};
    for (int i = 0; i < N_IN; ++i) p.in[i] = (const float*)d_in[i];
    p.out = (float*)d_out; p.ws = (unsigned char*)d_ws;
#ifdef EMU
    const int grid = 8;
#else
    static int grid = 0;
    if (!grid) { int dev = 0, cus = 0; hipGetDevice(&dev); hipDeviceGetAttribute(&cus, hipDeviceAttributeMultiprocessorCount, dev); grid = cus > 0 ? cus : 256; }
    if (ws_size < WS::TOTAL) { fprintf(stderr, "workspace too small: %zu < %zu\n", ws_size, (size_t)WS::TOTAL); }
#endif
#if MK_FUSED
#ifdef EMU
    emu_launch([](const void* a) { k_mega(*(const Params*)a); }, &p, grid, NTHR, LDS_BYTES);
#else
    static int fgrid = 0;
    if (!fgrid) {
        int per_cu = 0;
        hipFuncSetAttribute((const void*)k_mega, hipFuncAttributeMaxDynamicSharedMemorySize, LDS_BYTES);
        hipOccupancyMaxActiveBlocksPerMultiprocessor(&per_cu, (const void*)k_mega, NTHR, LDS_BYTES);
        fgrid = per_cu >= 1 ? grid : 0;
        if (!fgrid) fprintf(stderr, "k_mega: occupancy query returned %d\n", per_cu);
    }
    hipMemsetAsync(p.ws + WS::BAR, 0, WS::BAR_SZ, stream);
    if (fgrid) hipLaunchKernelGGL(k_mega, dim3(fgrid), dim3(NTHR), LDS_BYTES, stream, p);
#endif
#else
    launch_phase<PH_PROLOGUE>(p, 0, grid, stream);
    launch_phase<PH_NORM1>(p, 0, grid, stream);
    for (int l = 0; l < NL; ++l) {
        launch_phase<PH_INPROJ>(p, l, grid, stream);
        launch_phase<PH_PREP>(p, l, grid, stream);
        launch_phase<PH_MIX1>(p, l, grid, stream);
        launch_phase<PH_SCAN>(p, l, grid, stream);
        launch_phase<PH_MIX2>(p, l, grid, stream);
        launch_phase<PH_GLU>(p, l, grid, stream);
        launch_phase<PH_BRANCH>(p, l, grid, stream);
        launch_phase<PH_OUT>(p, l, grid, stream);
        launch_phase<PH_NORM2>(p, l, grid, stream);
        launch_phase<PH_TOPK>(p, l, grid, stream);
        launch_phase<PH_MOE1>(p, l, grid, stream);
        launch_phase<PH_MOE2>(p, l, grid, stream);
        launch_phase<PH_COMBINE>(p, l, grid, stream);
    }
#endif
}
```
